# Optimizing an MI355X kernel written in HIP

```python
import jax, jax.numpy as jnp
from jax import lax
import numpy as np

D_MODEL = 1024
BATCH = 16
SEQ = 2048
DEPTH = 2

CHUNK = 64
Q_BLOCK = 128
LN_EPS = 1e-5
DEEPNORM_ALPHA = (2 * DEPTH) ** 0.25
DEEPNORM_BETA = (8 * DEPTH) ** -0.25

MLSTM_HEADS = 4
MLSTM_DH = 128
MLSTM_W = MLSTM_HEADS * MLSTM_DH
LRU_W = 512
LRU_BLOCKS = 8
LRU_BD = LRU_W // LRU_BLOCKS
CONV_W = 4
LRU_C = 8.0
RET_HEADS = 4
RET_DK = 128
RET_DV = 128
RET_W = RET_HEADS * RET_DV
ROPE_BASE = 10000.0
FOX_HEADS = 4
FOX_DH = 128
FOX_W = FOX_HEADS * FOX_DH
N_BRANCH = 4
BRANCH_W = 512
D_FF = 4 * D_MODEL

SEGMENTS = (
    ("m_q", MLSTM_W), ("m_k", MLSTM_W), ("m_v", MLSTM_W), ("m_o", MLSTM_W),
    ("m_i", MLSTM_HEADS), ("m_f", MLSTM_HEADS),
    ("l_x", LRU_W), ("l_g", LRU_W),
    ("r_q", RET_HEADS * RET_DK), ("r_k", RET_HEADS * RET_DK), ("r_v", RET_W), ("r_g", RET_W),
    ("f_q", FOX_W), ("f_k", FOX_W), ("f_v", FOX_W), ("f_f", FOX_HEADS),
    ("gate", N_BRANCH * D_MODEL),
)
N_IN = sum(w for _, w in SEGMENTS)

kernel_name = "chunk_causal_hybrid_mlstm_rglru_retention_fox"


def _layernorm(x):
    xf = x.astype(jnp.float32)
    mu = jnp.mean(xf, axis=-1, keepdims=True)
    var = jnp.mean(jnp.square(xf - mu), axis=-1, keepdims=True)
    return ((xf - mu) * lax.rsqrt(var + LN_EPS)).astype(x.dtype)


def _head_norm(h, w):
    B, S, H, d = h.shape
    mu = jnp.mean(h, axis=-1, keepdims=True)
    var = jnp.mean(jnp.square(h - mu), axis=-1, keepdims=True)
    return ((h - mu) * lax.rsqrt(var + LN_EPS)).reshape(B, S, H * d) * w


def _split_combined(z):
    idx, acc = [], 0
    for _, w in SEGMENTS[:-1]:
        acc += w
        idx.append(acc)
    parts = jnp.split(z, idx, axis=-1)
    return {name: p for (name, _), p in zip(SEGMENTS, parts)}


def _to_chunks(t):
    B, S, H, d = t.shape
    return t.reshape(B, S // CHUNK, CHUNK, H, d).transpose(1, 0, 3, 2, 4)


def _from_chunks(t):
    nc, B, H, L, d = t.shape
    return t.transpose(1, 0, 3, 2, 4).reshape(B, nc * L, H, d)


def _gates_to_chunks(g):
    B, S, H = g.shape
    return g.reshape(B, S // CHUNK, CHUNK, H).transpose(1, 0, 3, 2)


def _mlstm(q, k, v, o_pre, i_pre, f_pre, norm_w):
    f32 = jnp.float32
    B, S, _ = q.shape
    H, dh = MLSTM_HEADS, MLSTM_DH
    qc = _to_chunks(q.astype(f32).reshape(B, S, H, dh))
    kc = _to_chunks(k.astype(f32).reshape(B, S, H, dh)) * dh ** -0.5
    vc = _to_chunks(v.astype(f32).reshape(B, S, H, dh))
    log_f = _gates_to_chunks(jax.nn.log_sigmoid(f_pre.astype(f32)))
    log_i = _gates_to_chunks(i_pre.astype(f32))
    causal = jnp.tril(jnp.ones((CHUNK, CHUNK), dtype=bool))

    def step(carry, inp):
        C, n, m = carry
        q_, k_, v_, lf, li = inp
        b = jnp.cumsum(lf, axis=-1)
        g = b[..., -1]
        d = jnp.where(causal, b[..., :, None] - b[..., None, :] + li[..., None, :], -jnp.inf)
        inter = b + m[..., None]
        m_t = jnp.maximum(inter, jnp.max(d, axis=-1))
        a_inter = jnp.exp(inter - m_t)
        s = jnp.einsum('bhtd,bhsd->bhts', q_, k_) * jnp.exp(d - m_t[..., None])
        num = a_inter[..., None] * jnp.einsum('bhtd,bhde->bhte', q_, C) + jnp.einsum('bhts,bhse->bhte', s, v_)
        den = a_inter * jnp.einsum('bhtd,bhd->bht', q_, n) + jnp.sum(s, axis=-1)
        h = num / jnp.maximum(jnp.abs(den), jnp.exp(-m_t))[..., None]
        ds = g[..., None] - b + li
        m_new = jnp.maximum(g + m, jnp.max(ds, axis=-1))
        ws = jnp.exp(ds - m_new[..., None])
        decay = jnp.exp(g + m - m_new)
        kw = k_ * ws[..., None]
        C_new = decay[..., None, None] * C + jnp.einsum('bhsd,bhse->bhde', kw, v_)
        n_new = decay[..., None] * n + jnp.sum(kw, axis=2)
        return (C_new, n_new, m_new), h

    init = (jnp.zeros((B, H, dh, dh), f32), jnp.zeros((B, H, dh), f32), jnp.zeros((B, H), f32))
    _, hc = lax.scan(step, init, (qc, kc, vc, log_f, log_i))
    o = jax.nn.sigmoid(o_pre.astype(f32)).reshape(B, S, H, dh)
    return _head_norm(o * _from_chunks(hc), norm_w)


def _causal_depthwise_conv(x, w, b):
    C = x.shape[-1]
    y = lax.conv_general_dilated(x, w[:, None, :], window_strides=(1,), padding=[(CONV_W - 1, 0)],
                                 dimension_numbers=('NWC', 'WIO', 'NWC'), feature_group_count=C)
    return y + b


def _rglru_branch(x_in, gate_in, conv_w, conv_b, w_a, b_a, w_x, b_x, lam):
    f32 = jnp.float32
    B, S, R = x_in.shape
    xc = _causal_depthwise_conv(x_in.astype(f32), conv_w.astype(f32), conv_b.astype(f32))
    xb = xc.reshape(B, S, LRU_BLOCKS, LRU_BD)
    r = jax.nn.sigmoid(jnp.einsum('bsnd,nde->bsne', xb, w_a).reshape(B, S, R) + b_a)
    i = jax.nn.sigmoid(jnp.einsum('bsnd,nde->bsne', xb, w_x).reshape(B, S, R) + b_x)
    log_a = -LRU_C * r * jax.nn.softplus(-lam)
    a = jnp.exp(log_a)
    u = jnp.sqrt(-jnp.expm1(2.0 * log_a)) * (i * xc)

    def combine(e1, e2):
        a1, u1 = e1
        a2, u2 = e2
        return a1 * a2, a2 * u1 + u2

    _, hseq = lax.associative_scan(combine, (a, u), axis=1)
    return hseq * jax.nn.gelu(gate_in.astype(f32))


def _rotary(t, positions):
    d = t.shape[-1]
    inv_freq = ROPE_BASE ** (-jnp.arange(0, d, 2, dtype=jnp.float32) / d)
    ang = positions.astype(jnp.float32)[..., None] * inv_freq
    cos = jnp.cos(ang)[:, :, None, :]
    sin = jnp.sin(ang)[:, :, None, :]
    t1, t2 = jnp.split(t, 2, axis=-1)
    return jnp.concatenate([t1 * cos - t2 * sin, t1 * sin + t2 * cos], axis=-1)


def _retention(q, k, v, g_pre, positions, norm_w):
    f32 = jnp.float32
    B, S, _ = q.shape
    H, dk, dv, L = RET_HEADS, RET_DK, RET_DV, CHUNK
    q = _rotary(q.astype(f32).reshape(B, S, H, dk), positions)
    k = _rotary(k.astype(f32).reshape(B, S, H, dk), positions) * dk ** -0.5
    v = v.astype(f32).reshape(B, S, H, dv)
    log_gamma = jnp.log1p(-jnp.exp2(-5.0 - jnp.arange(H, dtype=f32)))
    idx = jnp.arange(L, dtype=f32)
    rel = idx[:, None] - idx[None, :]
    intra = jnp.where(rel >= 0, jnp.exp(rel * log_gamma[:, None, None]), 0.0)
    q_decay = jnp.exp((idx + 1.0) * log_gamma[:, None])
    k_decay = jnp.exp((L - 1.0 - idx) * log_gamma[:, None])
    chunk_decay = jnp.exp(L * log_gamma)

    def step(state, inp):
        q_, k_, v_ = inp
        scores = jnp.einsum('bhtd,bhsd->bhts', q_, k_) * intra
        out = (jnp.einsum('bhts,bhse->bhte', scores, v_)
               + jnp.einsum('bhtd,bhde->bhte', q_ * q_decay[..., None], state))
        state = chunk_decay[:, None, None] * state + jnp.einsum('bhsd,bhse->bhde', k_ * k_decay[..., None], v_)
        return state, out

    init = jnp.zeros((B, H, dk, dv), f32)
    _, oc = lax.scan(step, init, (_to_chunks(q), _to_chunks(k), _to_chunks(v)))
    y = _head_norm(_from_chunks(oc), norm_w)
    return jax.nn.silu(g_pre.astype(f32)) * y


def _forgetting_attention(q, k, v, f_pre):
    f32 = jnp.float32
    B, S, _ = q.shape
    H, dh = FOX_HEADS, FOX_DH

    def heads(t):
        return t.astype(f32).reshape(B, S, H, dh).transpose(0, 2, 1, 3)

    q = heads(q) * dh ** -0.5
    k = heads(k)
    v = heads(v)
    cum_f = jnp.cumsum(jax.nn.log_sigmoid(f_pre.astype(f32)), axis=1).transpose(0, 2, 1)
    outs = []
    for blk in range(S // Q_BLOCK):
        lo, hi = blk * Q_BLOCK, (blk + 1) * Q_BLOCK
        logits = (jnp.einsum('bhqd,bhkd->bhqk', q[:, :, lo:hi], k[:, :, :hi])
                  + cum_f[:, :, lo:hi, None] - cum_f[:, :, None, :hi])
        mask = jnp.arange(lo, hi)[:, None] >= jnp.arange(hi)[None, :]
        p = jax.nn.softmax(jnp.where(mask, logits, -jnp.inf), axis=-1)
        outs.append(jnp.einsum('bhqk,bhkd->bhqd', p, v[:, :, :hi]))
    o = jnp.concatenate(outs, axis=2)
    return o.transpose(0, 2, 1, 3).reshape(B, S, H * dh)


def _hybrid_mixer(h, positions, w_in, b_in, m_norm, conv_w, conv_b, lru_wa, lru_ba, lru_wx, lru_bx,
                  lru_lam, r_norm, w_br, w_out, b_out):
    B, S, D = h.shape
    p = _split_combined(h @ w_in + b_in)
    y_m = _mlstm(p["m_q"], p["m_k"], p["m_v"], p["m_o"], p["m_i"], p["m_f"], m_norm)
    y_l = _rglru_branch(p["l_x"], p["l_g"], conv_w, conv_b, lru_wa, lru_ba, lru_wx, lru_bx, lru_lam)
    y_r = _retention(p["r_q"], p["r_k"], p["r_v"], p["r_g"], positions, r_norm)
    y_f = _forgetting_attention(p["f_q"], p["f_k"], p["f_v"], p["f_f"])
    branches = (y_m, y_l, y_r, y_f)
    gates = jax.nn.sigmoid(p["gate"].astype(jnp.float32))
    merged = gates[..., :D] * (branches[0].astype(h.dtype) @ w_br[0])
    for n in range(1, N_BRANCH):
        merged = merged + gates[..., n * D:(n + 1) * D] * (branches[n].astype(h.dtype) @ w_br[n])
    return merged.astype(h.dtype) @ w_out + b_out


def _sq_relu_mlp(h, w1, b1, w2, b2):
    return jnp.square(jax.nn.relu(h @ w1 + b1)) @ w2 + b2


def setup_inputs(seed: int = 0) -> dict:
    key = jax.random.key(seed)
    ks = jax.random.split(key, 32)
    f32 = jnp.float32

    def nrm(k, shape, s):
        return jax.random.normal(k, shape, f32) * s

    x = nrm(ks[0], (BATCH, SEQ, D_MODEL), 1.0)
    c = nrm(ks[1], (BATCH, D_MODEL), 1.0)
    offset = jax.random.randint(ks[2], (BATCH, 1), 0, 64, dtype=jnp.int32) * CHUNK
    positions = offset + jnp.arange(SEQ, dtype=jnp.int32)[None, :]
    w_ada = nrm(ks[3], (DEPTH, D_MODEL, 6 * D_MODEL), 0.25 * D_MODEL ** -0.5)
    b_ada = nrm(ks[4], (DEPTH, 6 * D_MODEL), 0.02)
    w_in = nrm(ks[5], (DEPTH, D_MODEL, N_IN), D_MODEL ** -0.5)
    seg_keys = jax.random.split(ks[6], len(SEGMENTS))
    parts = []
    for (name, width), sk in zip(SEGMENTS, seg_keys):
        base = nrm(sk, (DEPTH, width), 0.1 if name == "m_i" else 0.02)
        if name == "m_f":
            base = base + jnp.linspace(3.0, 6.0, width, dtype=f32)
        elif name == "f_f":
            base = base + jnp.linspace(1.0, 4.0, width, dtype=f32)
        parts.append(base)
    b_in = jnp.concatenate(parts, axis=-1)
    m_norm = 1.0 + nrm(ks[7], (DEPTH, MLSTM_W), 0.02)
    conv_w = nrm(ks[8], (DEPTH, CONV_W, LRU_W), CONV_W ** -0.5)
    conv_b = nrm(ks[9], (DEPTH, LRU_W), 0.02)
    lru_wa = nrm(ks[10], (DEPTH, LRU_BLOCKS, LRU_BD, LRU_BD), LRU_BD ** -0.5)
    lru_ba = nrm(ks[11], (DEPTH, LRU_W), 0.02)
    lru_wx = nrm(ks[12], (DEPTH, LRU_BLOCKS, LRU_BD, LRU_BD), LRU_BD ** -0.5)
    lru_bx = nrm(ks[13], (DEPTH, LRU_W), 0.02)
    u = jax.random.uniform(ks[14], (DEPTH, LRU_W), f32, 0.9, 0.999)
    pa = u ** (1.0 / LRU_C)
    lru_lam = jnp.log(pa) - jnp.log1p(-pa)
    r_norm = 1.0 + nrm(ks[15], (DEPTH, RET_W), 0.02)
    w_br = nrm(ks[16], (DEPTH, N_BRANCH, BRANCH_W, D_MODEL), BRANCH_W ** -0.5)
    w_out = nrm(ks[17], (DEPTH, D_MODEL, D_MODEL), DEEPNORM_BETA * D_MODEL ** -0.5)
    b_out = nrm(ks[18], (DEPTH, D_MODEL), 0.02)
    ln1_g = 1.0 + nrm(ks[19], (DEPTH, D_MODEL), 0.02)
    ln1_b = nrm(ks[20], (DEPTH, D_MODEL), 0.02)
    w_ff1 = nrm(ks[21], (DEPTH, D_MODEL, D_FF), D_MODEL ** -0.5)
    b_ff1 = nrm(ks[22], (DEPTH, D_FF), 0.02)
    w_ff2 = nrm(ks[23], (DEPTH, D_FF, D_MODEL), DEEPNORM_BETA * D_FF ** -0.5)
    b_ff2 = nrm(ks[24], (DEPTH, D_MODEL), 0.02)
    ln2_g = 1.0 + nrm(ks[25], (DEPTH, D_MODEL), 0.02)
    ln2_b = nrm(ks[26], (DEPTH, D_MODEL), 0.02)
    return {"x": x, "c": c, "positions": positions, "w_ada": w_ada, "b_ada": b_ada,
            "w_in": w_in, "b_in": b_in, "m_norm": m_norm, "conv_w": conv_w, "conv_b": conv_b,
            "lru_wa": lru_wa, "lru_ba": lru_ba, "lru_wx": lru_wx, "lru_bx": lru_bx, "lru_lam": lru_lam,
            "r_norm": r_norm, "w_br": w_br, "w_out": w_out, "b_out": b_out,
            "ln1_g": ln1_g, "ln1_b": ln1_b, "w_ff1": w_ff1, "b_ff1": b_ff1,
            "w_ff2": w_ff2, "b_ff2": b_ff2, "ln2_g": ln2_g, "ln2_b": ln2_b}


def reference(x, c, positions, w_ada, b_ada, w_in, b_in, m_norm, conv_w, conv_b,
              lru_wa, lru_ba, lru_wx, lru_bx, lru_lam, r_norm, w_br, w_out, b_out,
              ln1_g, ln1_b, w_ff1, b_ff1, w_ff2, b_ff2, ln2_g, ln2_b):
    cond = jax.nn.silu(c)
    for l in range(DEPTH):
        mod = cond @ w_ada[l] + b_ada[l]
        sh1, sc1, g1, sh2, sc2, g2 = (m[:, None, :] for m in jnp.split(mod, 6, axis=-1))
        h = _layernorm(x) * (1.0 + sc1) + sh1
        y = _hybrid_mixer(h, positions, w_in[l], b_in[l], m_norm[l], conv_w[l], conv_b[l],
                          lru_wa[l], lru_ba[l], lru_wx[l], lru_bx[l], lru_lam[l], r_norm[l],
                          w_br[l], w_out[l], b_out[l])
        x = _layernorm(DEEPNORM_ALPHA * x + (1.0 + g1) * y) * ln1_g[l] + ln1_b[l]
        h = _layernorm(x) * (1.0 + sc2) + sh2
        y = _sq_relu_mlp(h, w_ff1[l], b_ff1[l], w_ff2[l], b_ff2[l])
        x = _layernorm(DEEPNORM_ALPHA * x + (1.0 + g2) * y) * ln2_g[l] + ln2_b[l]
    return x
```

```cpp
#include <hip/hip_runtime.h>
#include <hip/hip_cooperative_groups.h>
#include <cstdio>
namespace cg = cooperative_groups;

typedef unsigned short u16;
typedef unsigned int u32;
typedef __attribute__((ext_vector_type(8))) short bf16x8;
typedef __attribute__((ext_vector_type(4))) float f32x4;

#define DEV __device__ __forceinline__
__device__ __forceinline__ int threadIdx_x_raw() { return (int)threadIdx.x; }

#ifndef MULTI_LAUNCH
#define MULTI_LAUNCH 0
#endif

constexpr int SMEM_BYTES = 80384;
constexpr int BF = 256, BTK = 128;
constexpr int ZW = 6720;
constexpr int LDH = 1088;
constexpr int LDU = 4160;
constexpr int LDB = 544;
constexpr int LDW1 = 1088, LDW5 = 544, LDW4 = 4160;
constexpr int NIN = 10764;
constexpr int GATE_ROW0 = 6784;
constexpr size_t OFF_WIN = 0, OFF_WBR = OFF_WIN + (size_t)10880 * LDW1, OFF_WOUT = OFF_WBR + (size_t)4 * 1024 * LDW5,
                 OFF_W1 = OFF_WOUT + (size_t)1024 * LDW1, OFF_W2 = OFF_W1 + (size_t)4096 * LDW1,
                 WL = OFF_W2 + (size_t)1024 * LDW4;
constexpr float ALPHA = 1.4142135623730951f;
constexpr float LOG2E = 1.4426950408889634f;

struct Params {
  const float *x, *c; const int* pos;
  const float *w_ada, *b_ada, *w_in, *b_in, *m_norm, *conv_w, *conv_b, *lru_wa, *lru_ba, *lru_wx, *lru_bx, *lru_lam,
      *r_norm, *w_br, *w_out, *b_out, *ln1_g, *ln1_b, *w_ff1, *b_ff1, *w_ff2, *b_ff2, *ln2_g, *ln2_b;
  float* out;
  u16* Wb; u16* h; u16* zreg; u16* br; float* small; float* mod; float* h0f; float* qk0; unsigned* bar;
};

typedef __attribute__((ext_vector_type(4))) unsigned int u32x4;
DEV bf16x8 mk8(u32 a, u32 b, u32 c, u32 d) { u32x4 t = {a, b, c, d}; return __builtin_bit_cast(bf16x8, t); }
DEV u32 wsel(u32x4 q, int i) { return q[i]; }

DEV int ltid() { int t = threadIdx_x_raw(); asm volatile("" : "+v"(t)); return t; }
typedef __attribute__((ext_vector_type(2))) __bf16 bf16v2;
typedef __attribute__((ext_vector_type(2))) float f32v2;
DEV u32 pack2(float a, float b) { f32v2 v = {a, b}; return __builtin_bit_cast(u32, __builtin_convertvector(v, bf16v2)); }
DEV u16 f2bf(float f) { return (u16)(pack2(f, 0.f) & 0xffffu); }
DEV float bf2f(u32 h) { return __uint_as_float(h << 16); }
DEV float bflo(u32 w) { return __uint_as_float(w << 16); }
DEV float bfhi(u32 w) { return __uint_as_float(w & 0xffff0000u); }
DEV f32x4 mfma16(bf16x8 a, bf16x8 b, f32x4 c) { return __builtin_amdgcn_mfma_f32_16x16x32_bf16(a, b, c, 0, 0, 0); }
DEV float fexp2(float x) { return __builtin_amdgcn_exp2f(x); }
DEV float fexp(float x) { return __builtin_amdgcn_exp2f(x * LOG2E); }
DEV float frcp(float x) { return __builtin_amdgcn_rcpf(x); }
DEV float sigmoidf_(float x) { return frcp(1.f + fexp(-x)); }
DEV float logsigf_(float x) { return fminf(x, 0.f) - log1pf(expf(-fabsf(x))); }
DEV float wave_sum(float v) {
#pragma unroll
  for (int m = 32; m >= 1; m >>= 1) v += __shfl_xor(v, m);
  return v;
}
DEV int sw8(int row, int chunk) { return row * 128 + ((chunk ^ ((row >> 1) & 7)) << 4); }
DEV int sw16(int row, int chunk) { return row * 256 + ((chunk ^ (row & 15)) << 4); }
DEV bf16x8 lds128(const char* p) { return *(const bf16x8*)p; }
DEV float4 ld_nt16(const float* p) { f32x4 v = __builtin_nontemporal_load((const f32x4*)p); return make_float4(v[0], v[1], v[2], v[3]); }
DEV void st_nt16(float* p, float a, float b, float c, float d) { f32x4 v = {a, b, c, d}; __builtin_nontemporal_store(v, (f32x4*)p); }

struct GOp { const u16* W; int ldw; const u16* X; int ldx; int K; };
template <int FT, int TT>
struct GPipe { u32x4 rw[FT / 32], rx[TT / 32]; };

#define G_LOAD(RW, RX, WP, LDW, XP, LDX)                                                           \
  {                                                                                                \
    _Pragma("unroll") for (int i = 0; i < WI; ++i) RW[i] = *(const u32x4*)((WP) + (size_t)i * 32 * (LDW)); \
    _Pragma("unroll") for (int i = 0; i < XI; ++i) RX[i] = *(const u32x4*)((XP) + (size_t)i * 32 * (LDX)); \
  }
#define G_STORE(ST, RW, RX)                                                                        \
  {                                                                                                \
    _Pragma("unroll") for (int i = 0; i < WI; ++i) *(u32x4*)(ST + sw8(lr + i * 32, lc)) = RW[i];  \
    _Pragma("unroll") for (int i = 0; i < XI; ++i) *(u32x4*)(ST + WBYTES + sw8(lr + i * 32, lc)) = RX[i]; \
  }
#define G_COMPUTE(ST)                                                                              \
  {                                                                                                \
    _Pragma("unroll") for (int ks = 0; ks < 2; ++ks) {                                             \
      bf16x8 bx[XI];                                                                               \
      _Pragma("unroll") for (int i = 0; i < XI; ++i) bx[i] = lds128(ST + WBYTES + sw8(wt * (TT / 2) + i * 16 + fr, ks * 4 + fq)); \
      _Pragma("unroll") for (int ah = 0; ah < WI; ah += 4) {                                       \
        bf16x8 af[4];                                                                              \
        _Pragma("unroll") for (int i = 0; i < 4; ++i) af[i] = lds128(ST + sw8(wf * (FT / 2) + (ah + i) * 16 + fr, ks * 4 + fq)); \
        _Pragma("unroll") for (int a = 0; a < 4; ++a)                                              \
          _Pragma("unroll") for (int b = 0; b < XI; ++b) acc[ah + a][b] = mfma16(af[a], bx[b], acc[ah + a][b]); \
      }                                                                                            \
    }                                                                                              \
  }

template <int FT, int TT>
DEV void gemm_prime(GPipe<FT, TT>& pp, const GOp& op, char* smem) {
  constexpr int WI = FT / 32, XI = TT / 32;
  constexpr int WBYTES = FT * 128;
  const int tid = ltid();
  const int lr = tid >> 3, lc = tid & 7;
  const u16* wp = op.W + (size_t)lr * op.ldw + lc * 8;
  const u16* xp = op.X + (size_t)lr * op.ldx + lc * 8;
  __syncthreads();
  G_LOAD(pp.rw, pp.rx, wp, op.ldw, xp, op.ldx);
  G_STORE(smem, pp.rw, pp.rx);
  __syncthreads();
}

template <int FT, int TT>
DEV void gemm_mainloop(GPipe<FT, TT>& pp, const GOp& op, const GOp& nx, f32x4 (&acc)[FT / 32][TT / 32], char* smem) {
  constexpr int WI = FT / 32, XI = TT / 32;
  constexpr int WBYTES = FT * 128, XBYTES = TT * 128, STAGE = WBYTES + XBYTES;
  const int tid = ltid(), lane = tid & 63, wv = tid >> 6;
  const int wf = wv >> 1, wt = wv & 1, fr = lane & 15, fq = lane >> 4;
  const int lr = tid >> 3, lc = tid & 7;
  const u16* wp = op.W + (size_t)lr * op.ldw + lc * 8;
  const u16* xp = op.X + (size_t)lr * op.ldx + lc * 8;
  const u16* nwp = nx.W + (size_t)lr * nx.ldw + lc * 8;
  const u16* nxp = nx.X + (size_t)lr * nx.ldx + lc * 8;
  char* st0 = smem;
  char* st1 = smem + STAGE;
  const int nk = op.K >> 6;
  for (int kt = 0; kt < nk; kt += 2) {
    G_LOAD(pp.rw, pp.rx, wp + (kt + 1) * 64, op.ldw, xp + (kt + 1) * 64, op.ldx);
    G_COMPUTE(st0);
    G_STORE(st1, pp.rw, pp.rx);
    __syncthreads();
    {
      const bool cur = (kt + 2 < nk);
      const u16* a = cur ? wp + (kt + 2) * 64 : nwp;
      const u16* b = cur ? xp + (kt + 2) * 64 : nxp;
      const int la = cur ? op.ldw : nx.ldw, lb = cur ? op.ldx : nx.ldx;
      G_LOAD(pp.rw, pp.rx, a, la, b, lb);
    }
    G_COMPUTE(st1);
    G_STORE(st0, pp.rw, pp.rx);
    __syncthreads();
  }
}
template <int FT, int TT>
DEV void gemm_mainloop_sb(GPipe<FT, TT>& pp, const GOp& op, const GOp& nx, f32x4 (&acc)[FT / 32][TT / 32], char* smem) {
  constexpr int WI = FT / 32, XI = TT / 32;
  constexpr int WBYTES = FT * 128;
  const int tid = ltid(), lane = tid & 63, wv = tid >> 6;
  const int wf = wv >> 1, wt = wv & 1, fr = lane & 15, fq = lane >> 4;
  const int lr = tid >> 3, lc = tid & 7;
  const u16* wp = op.W + (size_t)lr * op.ldw + lc * 8;
  const u16* xp = op.X + (size_t)lr * op.ldx + lc * 8;
  const u16* nwp = nx.W + (size_t)lr * nx.ldw + lc * 8;
  const u16* nxp = nx.X + (size_t)lr * nx.ldx + lc * 8;
  char* st0 = smem;
  const int nk = op.K >> 6;
  for (int kt = 0; kt < nk; ++kt) {
    {
      const bool cur = (kt + 1 < nk);
      const u16* a = cur ? wp + (kt + 1) * 64 : nwp;
      const u16* b = cur ? xp + (kt + 1) * 64 : nxp;
      const int la = cur ? op.ldw : nx.ldw, lb = cur ? op.ldx : nx.ldx;
      G_LOAD(pp.rw, pp.rx, a, la, b, lb);
    }
    G_COMPUTE(st0);
    __syncthreads();
    G_STORE(st0, pp.rw, pp.rx);
    __syncthreads();
  }
}
#undef G_LOAD
#undef G_STORE
#undef G_COMPUTE

DEV void tile_map(int i, int TM, int TN, int& tm, int& tn) {
  const int xcd = i & 7, j = i >> 3;
  const int tmx = TM >> 3, per = 8 * TN;
  const int g = j / per, r = j - g * per;
  tn = r >> 3;
  tm = xcd * tmx + g * 8 + (r & 7);
}

DEV int winmap(int n) {
  if (n < 2048) return n;
  if (n < 6656) return n + 8;
  if (n < 6664) return 2048 + (n - 6656);
  if (n < 6668) return n;
  if (n < GATE_ROW0) return -1;
  return 6668 + (n - GATE_ROW0);
}

DEV void transpose_tile(const float* __restrict__ src, int ld_src, u16* __restrict__ dst, int ld_dst, int k0, int n0,
                        bool win, char* smem) {
  float* tile = (float*)smem;
  const int tid = ltid();
  {
    const int nn = tid & 127;
    const int col = win ? winmap(n0 + nn) : (n0 + nn);
    float v[32];
#pragma unroll
    for (int r = 0; r < 32; ++r) {
      const int kk = r * 2 + (tid >> 7);
      v[r] = (col >= 0) ? src[(size_t)(k0 + kk) * ld_src + col] : 0.f;
    }
#pragma unroll
    for (int r = 0; r < 32; ++r) tile[(r * 2 + (tid >> 7)) * 129 + nn] = v[r];
  }
  __syncthreads();
  {
    const int nn = tid >> 1, kq = (tid & 1) * 32;
    u32 w[16];
#pragma unroll
    for (int i = 0; i < 16; ++i) w[i] = pack2(tile[(kq + 2 * i) * 129 + nn], tile[(kq + 2 * i + 1) * 129 + nn]);
    u16* d = dst + (size_t)(n0 + nn) * ld_dst + k0 + kq;
#pragma unroll
    for (int i = 0; i < 4; ++i) *(uint4*)(d + 8 * i) = make_uint4(w[4 * i], w[4 * i + 1], w[4 * i + 2], w[4 * i + 3]);
  }
  __syncthreads();
}

template <bool SILU>
DEV void gemv16_task(const float* __restrict__ A, const float* __restrict__ W, size_t ldw, const float* __restrict__ bias,
                     float* __restrict__ out, int ldo, char* smem) {
  float* cs = (float*)smem;
  const int tid = ltid();
  for (int i = tid; i < 16384; i += 256) {
    const float v = A[i];
    cs[i] = SILU ? v / (1.f + expf(-v)) : v;
  }
  __syncthreads();
  const int ks = tid >> 5, cc = tid & 31;
  const float* w = W + (size_t)(ks * 128) * ldw + cc;
  float acc[16];
#pragma unroll
  for (int b = 0; b < 16; ++b) acc[b] = 0.f;
#pragma unroll 8
  for (int k = 0; k < 128; ++k) {
    const float wv = w[(size_t)k * ldw];
    const float* cp = cs + ks * 128 + k;
#pragma unroll
    for (int b = 0; b < 16; ++b) acc[b] += cp[b * 1024] * wv;
  }
  __syncthreads();
  float* red = (float*)smem;
#pragma unroll
  for (int b = 0; b < 16; ++b) red[(ks * 16 + b) * 32 + cc] = acc[b];
  __syncthreads();
  for (int o = tid; o < 512; o += 256) {
    const int b = o >> 5, c = o & 31;
    float s = 0.f;
#pragma unroll
    for (int q = 0; q < 8; ++q) s += red[(q * 16 + b) * 32 + c];
    out[(size_t)b * ldo + c] = s + bias[c];
  }
  __syncthreads();
}

DEV void mod_task(const Params& p, int m, char* smem) {
  const int layer = m / 192, cb = (m % 192) * 32;
  gemv16_task<true>(p.c, p.w_ada + (size_t)layer * 1024 * 6144 + cb, 6144, p.b_ada + layer * 6144 + cb,
                    p.mod + (size_t)layer * 16 * 6144 + cb, 6144, smem);
}

DEV void qk0_task(const Params& p, int layer, int j, char* smem) {
  const int grp = j >> 4, c0 = (j & 15) * 32;
  const int ocol = (grp == 0 ? 0 : (grp == 1 ? 512 : (grp == 2 ? 3080 : 3592))) + c0;
  gemv16_task<false>(p.h0f, p.w_in + (size_t)layer * 1024 * NIN + ocol, NIN, p.b_in + (size_t)layer * NIN + ocol,
                     p.qk0 + grp * 512 + c0, 2048, smem);
}

DEV void phase_prep(const Params& p, char* smem) {
  constexpr int NMOD = 384, PER_LAYER = 1360 + 256 + 128 + 512 + 512;
  unsigned* ctr = p.bar + 36;
  int* s_item = (int*)(smem + SMEM_BYTES - 16);
  for (;;) {
    if (threadIdx.x == 0) *s_item = (int)atomicAdd(ctr, 1u);
    __syncthreads();
    const int t = *s_item;
    __syncthreads();
    if (t >= NMOD + 2 * PER_LAYER) break;
    if (t < NMOD) { mod_task(p, t, smem); continue; }
    const int tt = t - NMOD;
    const int layer = tt / PER_LAYER;
    int r = tt - layer * PER_LAYER;
    u16* W = p.Wb + (size_t)layer * WL;
    if (r < 1360) {
      transpose_tile(p.w_in + (size_t)layer * 1024 * NIN, NIN, W + OFF_WIN, LDW1, (r & 15) * 64, (r >> 4) * 128, true, smem);
    } else if (r < 1616) {
      r -= 1360;
      const int n = r >> 6, r3 = r & 63;
      transpose_tile(p.w_br + ((size_t)layer * 4 + n) * 512 * 1024, 1024, W + OFF_WBR + (size_t)n * 1024 * LDW5, LDW5,
                     (r3 & 7) * 64, (r3 >> 3) * 128, false, smem);
    } else if (r < 1744) {
      r -= 1616;
      transpose_tile(p.w_out + (size_t)layer * 1024 * 1024, 1024, W + OFF_WOUT, LDW1, (r & 15) * 64, (r >> 4) * 128, false, smem);
    } else if (r < 2256) {
      r -= 1744;
      transpose_tile(p.w_ff1 + (size_t)layer * 1024 * 4096, 4096, W + OFF_W1, LDW1, (r & 15) * 64, (r >> 4) * 128, false, smem);
    } else {
      r -= 2256;
      transpose_tile(p.w_ff2 + (size_t)layer * 4096 * 1024, 1024, W + OFF_W2, LDW4, (r & 63) * 64, (r >> 6) * 128, false, smem);
    }
  }
}

DEV void ln_stats(const float (&v)[16], float& mean, float& rstd) {
  float s = 0.f;
#pragma unroll
  for (int i = 0; i < 16; ++i) s += v[i];
  mean = wave_sum(s) * (1.f / 1024.f);
  float q = 0.f;
#pragma unroll
  for (int i = 0; i < 16; ++i) { const float d = v[i] - mean; q += d * d; }
  rstd = rsqrtf(wave_sum(q) * (1.f / 1024.f) + 1e-5f);
}

DEV void mod_store_h(const float (&xn)[16], const float* modb, int shoff, int scoff, u16* hrow, int lane, float* h0row) {
  float mean, rstd;
  ln_stats(xn, mean, rstd);
#pragma unroll
  for (int i = 0; i < 4; ++i) {
    const int col = i * 256 + lane * 4;
    const float4 sh = *(const float4*)(modb + shoff + col);
    const float4 sc = *(const float4*)(modb + scoff + col);
    const float h0 = (xn[i * 4 + 0] - mean) * rstd * (1.f + sc.x) + sh.x;
    const float h1 = (xn[i * 4 + 1] - mean) * rstd * (1.f + sc.y) + sh.y;
    const float h2 = (xn[i * 4 + 2] - mean) * rstd * (1.f + sc.z) + sh.z;
    const float h3 = (xn[i * 4 + 3] - mean) * rstd * (1.f + sc.w) + sh.w;
    *(uint2*)(hrow + col) = make_uint2(pack2(h0, h1), pack2(h2, h3));
    if (h0row) *(float4*)(h0row + col) = make_float4(h0, h1, h2, h3);
  }
}

DEV void phase_lnmod0(const Params& p) {
  const int lane = ltid() & 63, wv = ltid() >> 6;
  for (int row = blockIdx.x * 4 + wv; row < 32768; row += gridDim.x * 4) {
    float v[16];
#pragma unroll
    for (int i = 0; i < 4; ++i) {
      const float4 xv = ld_nt16(p.x + (size_t)row * 1024 + i * 256 + lane * 4);
      v[i * 4 + 0] = xv.x; v[i * 4 + 1] = xv.y; v[i * 4 + 2] = xv.z; v[i * 4 + 3] = xv.w;
    }
    const float* modb = p.mod + (size_t)(0 * 16 + (row >> 11)) * 6144;
    mod_store_h(v, modb, 0, 1024, p.h + (size_t)row * LDH, lane, (row & 2047) == 0 ? p.h0f + (row >> 11) * 1024 : nullptr);
  }
}

DEV void phase_lnres(const Params& p, const float* xin, const u16* y, int layer, int sub) {
  const int lane = ltid() & 63, wv = ltid() >> 6;
  const int goff = sub == 0 ? 2048 : 5120;
  const float* gam = (sub == 0 ? p.ln1_g : p.ln2_g) + layer * 1024;
  const float* bet = (sub == 0 ? p.ln1_b : p.ln2_b) + layer * 1024;
  const bool has_next = (sub == 0) || (layer + 1 < 2);
  const int nlayer = sub == 0 ? layer : layer + 1;
  const int shoff = sub == 0 ? 3072 : 0, scoff = sub == 0 ? 4096 : 1024;
  const int stride = gridDim.x * 4;
  int row = blockIdx.x * 4 + wv;
  float4 xq[4]; uint2 yq[4];
  if (row < 32768) {
#pragma unroll
    for (int i = 0; i < 4; ++i) {
      xq[i] = ld_nt16(xin + (size_t)row * 1024 + i * 256 + lane * 4);
      yq[i] = *(const uint2*)(y + (size_t)row * LDH + i * 256 + lane * 4);
    }
  }
  for (; row < 32768; row += stride) {
    const int b = row >> 11;
    const float* modb = p.mod + (size_t)(layer * 16 + b) * 6144;
    float4 xn[4]; uint2 yn[4];
    {
      const int nrow = (row + stride < 32768) ? row + stride : row;
#pragma unroll
      for (int i = 0; i < 4; ++i) {
        xn[i] = ld_nt16(xin + (size_t)nrow * 1024 + i * 256 + lane * 4);
        yn[i] = *(const uint2*)(y + (size_t)nrow * LDH + i * 256 + lane * 4);
      }
    }
    float v[16];
#pragma unroll
    for (int i = 0; i < 4; ++i) {
      const int col = i * 256 + lane * 4;
      const float4 xv = xq[i];
      const uint2 yv = yq[i];
      const float4 gv = *(const float4*)(modb + goff + col);
      v[i * 4 + 0] = ALPHA * xv.x + (1.f + gv.x) * bflo(yv.x);
      v[i * 4 + 1] = ALPHA * xv.y + (1.f + gv.y) * bfhi(yv.x);
      v[i * 4 + 2] = ALPHA * xv.z + (1.f + gv.z) * bflo(yv.y);
      v[i * 4 + 3] = ALPHA * xv.w + (1.f + gv.w) * bfhi(yv.y);
    }
    float mean, rstd;
    ln_stats(v, mean, rstd);
#pragma unroll
    for (int i = 0; i < 4; ++i) {
      const int col = i * 256 + lane * 4;
      const float4 ga = *(const float4*)(gam + col);
      const float4 be = *(const float4*)(bet + col);
      v[i * 4 + 0] = (v[i * 4 + 0] - mean) * rstd * ga.x + be.x;
      v[i * 4 + 1] = (v[i * 4 + 1] - mean) * rstd * ga.y + be.y;
      v[i * 4 + 2] = (v[i * 4 + 2] - mean) * rstd * ga.z + be.z;
      v[i * 4 + 3] = (v[i * 4 + 3] - mean) * rstd * ga.w + be.w;
      st_nt16(p.out + (size_t)row * 1024 + col, v[i * 4 + 0], v[i * 4 + 1], v[i * 4 + 2], v[i * 4 + 3]);
    }
    if (has_next) {
      const float* modn = p.mod + (size_t)(nlayer * 16 + b) * 6144;
      mod_store_h(v, modn, shoff, scoff, p.h + (size_t)row * LDH, lane,
                  (sub == 1 && (row & 2047) == 0) ? p.h0f + (row >> 11) * 1024 : nullptr);
    }
#pragma unroll
    for (int i = 0; i < 4; ++i) { xq[i] = xn[i]; yq[i] = yn[i]; }
  }
}

DEV void phase_zgemm(const Params& p, int layer, int half, char* smem) {
  const u16* WinT = p.Wb + (size_t)layer * WL + OFF_WIN;
  const u16* hb = p.h + (size_t)half * 16384 * LDH;
  const float* bin = p.b_in + (size_t)layer * NIN;
  const int lane = ltid() & 63, wv = ltid() >> 6, wf = wv >> 1, wt = wv & 1, fr = lane & 15, fq = lane >> 4;
  constexpr int TM = 16384 / BTK, TNZ = 6656 / BF, TN = TNZ + 1;
  GPipe<BF, BTK> pp;
  bool primed = false;
  for (int i = blockIdx.x; i < TM * TN; i += gridDim.x) {
    int tm, tn;
    tile_map(i, TM, TN, tm, tn);
    const GOp op{WinT + (size_t)tn * BF * LDW1, LDW1, hb + (size_t)tm * BTK * LDH, LDH, 1024};
    GOp nx = op;
    if (i + (int)gridDim.x < TM * TN) {
      int tm2, tn2;
      tile_map(i + gridDim.x, TM, TN, tm2, tn2);
      nx.W = WinT + (size_t)tn2 * BF * LDW1; nx.X = hb + (size_t)tm2 * BTK * LDH;
    }
    if (!primed) { gemm_prime<BF, BTK>(pp, op, smem); primed = true; }
    f32x4 acc[BF / 32][BTK / 32];
#pragma unroll
    for (int a = 0; a < BF / 32; ++a)
#pragma unroll
      for (int b = 0; b < BTK / 32; ++b) acc[a][b] = f32x4{0.f, 0.f, 0.f, 0.f};
    gemm_mainloop_sb<BF, BTK>(pp, op, nx, acc, smem);
    if (tn < TNZ) {
#pragma unroll
      for (int a = 0; a < BF / 32; ++a) {
        const int feat = tn * BF + wf * (BF / 2) + a * 16 + fq * 4;
        const int oc = feat < 2048 ? feat : feat + 8;
        const float b0 = bin[oc], b1 = bin[oc + 1], b2 = bin[oc + 2], b3 = bin[oc + 3];
#pragma unroll
        for (int b = 0; b < BTK / 32; ++b) {
          const int tok = tm * BTK + wt * (BTK / 2) + b * 16 + fr;
          *(uint2*)(p.zreg + (size_t)tok * ZW + feat) =
              make_uint2(pack2(acc[a][b][0] + b0, acc[a][b][1] + b1), pack2(acc[a][b][2] + b2, acc[a][b][3] + b3));
        }
      }
    } else if (wf == 0) {
      const int c = fq * 4;
      float bb[4];
#pragma unroll
      for (int j = 0; j < 4; ++j) {
        const int cc = c + j;
        bb[j] = cc < 8 ? bin[2048 + cc] : (cc < 12 ? bin[6664 + cc - 8] : 0.f);
      }
#pragma unroll
      for (int b = 0; b < BTK / 32; ++b) {
        const int tok = half * 16384 + tm * BTK + wt * (BTK / 2) + b * 16 + fr;
        *(float4*)(p.small + (size_t)tok * 16 + c) =
            make_float4(acc[0][b][0] + bb[0], acc[0][b][1] + bb[1], acc[0][b][2] + bb[2], acc[0][b][3] + bb[3]);
      }
    }
  }
  if (half == 0) {
    for (int j = (int)gridDim.x - 1 - (int)blockIdx.x; j < 64; j += gridDim.x) {
      __syncthreads();
      qk0_task(p, layer, j, smem);
    }
  }
}

template <int MODE>
DEV void phase_gemm(const u16* Wt, int ldw, const u16* X, int ldx, const float* bias, u16* out, int ldo, int N, int K, char* smem) {
  const int lane = ltid() & 63, wv = ltid() >> 6, wf = wv >> 1, wt = wv & 1, fr = lane & 15, fq = lane >> 4;
  const int TM = 32768 / BTK, TN = N / BF;
  GPipe<BF, BTK> pp;
  bool primed = false;
  for (int i = blockIdx.x; i < TM * TN; i += gridDim.x) {
    int tm, tn;
    tile_map(i, TM, TN, tm, tn);
    const GOp op{Wt + (size_t)tn * BF * ldw, ldw, X + (size_t)tm * BTK * ldx, ldx, K};
    GOp nx = op;
    if (i + (int)gridDim.x < TM * TN) {
      int tm2, tn2;
      tile_map(i + gridDim.x, TM, TN, tm2, tn2);
      nx.W = Wt + (size_t)tn2 * BF * ldw; nx.X = X + (size_t)tm2 * BTK * ldx;
    }
    if (!primed) { gemm_prime<BF, BTK>(pp, op, smem); primed = true; }
    f32x4 acc[BF / 32][BTK / 32];
#pragma unroll
    for (int a = 0; a < BF / 32; ++a)
#pragma unroll
      for (int b = 0; b < BTK / 32; ++b) acc[a][b] = f32x4{0.f, 0.f, 0.f, 0.f};
    gemm_mainloop_sb<BF, BTK>(pp, op, nx, acc, smem);
#pragma unroll
    for (int a = 0; a < BF / 32; ++a) {
      const int feat = tn * BF + wf * (BF / 2) + a * 16 + fq * 4;
      const float4 bv = *(const float4*)(bias + feat);
#pragma unroll
      for (int b = 0; b < BTK / 32; ++b) {
        const int tok = tm * BTK + wt * (BTK / 2) + b * 16 + fr;
        float v0 = acc[a][b][0] + bv.x, v1 = acc[a][b][1] + bv.y, v2 = acc[a][b][2] + bv.z, v3 = acc[a][b][3] + bv.w;
        if (MODE == 1) {
          v0 = fmaxf(v0, 0.f); v0 *= v0; v1 = fmaxf(v1, 0.f); v1 *= v1;
          v2 = fmaxf(v2, 0.f); v2 *= v2; v3 = fmaxf(v3, 0.f); v3 *= v3;
        }
        *(uint2*)(out + (size_t)tok * ldo + feat) = make_uint2(pack2(v0, v1), pack2(v2, v3));
      }
    }
  }
}

DEV void phase_merge(const Params& p, int layer, u16* merged, char* smem) {
  const u16* W = p.Wb + (size_t)layer * WL;
  const float* bg = p.b_in + (size_t)layer * NIN + 6668;
  const int lane = ltid() & 63, wv = ltid() >> 6, wf = wv >> 1, wt = wv & 1, fr = lane & 15, fq = lane >> 4;
  constexpr int TM = 256, TN = 8;
  GPipe<128, 128> pp;
  bool primed = false;
  for (int i = blockIdx.x; i < TM * TN; i += gridDim.x) {
    int tm, tn;
    tile_map(i, TM, TN, tm, tn);
    int tm2 = tm, tn2 = tn;
    const bool has_next = (i + (int)gridDim.x < TM * TN);
    if (has_next) tile_map(i + gridDim.x, TM, TN, tm2, tn2);
    u32 pm[4][4][2];
#pragma unroll
    for (int a = 0; a < 4; ++a)
#pragma unroll
      for (int b = 0; b < 4; ++b) { pm[a][b][0] = 0u; pm[a][b][1] = 0u; }
    for (int n = 0; n < 4; ++n) {
      const GOp opg{W + OFF_WIN + (size_t)(GATE_ROW0 + n * 1024 + tn * 128) * LDW1, LDW1, p.h + (size_t)tm * 128 * LDH, LDH, 1024};
      const GOp opb{W + OFF_WBR + (size_t)n * 1024 * LDW5 + (size_t)(tn * 128) * LDW5, LDW5,
                    p.br + (size_t)n * 32768 * LDB + (size_t)tm * 128 * LDB, LDB, 512};
      const int nn = (n + 1) & 3, tmn = (n < 3) ? tm : tm2, tnn = (n < 3) ? tn : tn2;
      GOp opn{W + OFF_WIN + (size_t)(GATE_ROW0 + nn * 1024 + tnn * 128) * LDW1, LDW1, p.h + (size_t)tmn * 128 * LDH, LDH, 1024};
      if (n == 3 && !has_next) opn = opb;
      if (!primed) { gemm_prime<128, 128>(pp, opg, smem); primed = true; }
      u32 gp[4][4][2];
      {
        f32x4 accG[4][4];
#pragma unroll
        for (int a = 0; a < 4; ++a)
#pragma unroll
          for (int b = 0; b < 4; ++b) accG[a][b] = f32x4{0.f, 0.f, 0.f, 0.f};
        gemm_mainloop_sb<128, 128>(pp, opg, opb, accG, smem);
#pragma unroll
        for (int a = 0; a < 4; ++a) {
          const float* bp = bg + n * 1024 + tn * 128 + wf * 64 + a * 16 + fq * 4;
          const float b0 = bp[0], b1 = bp[1], b2 = bp[2], b3 = bp[3];
#pragma unroll
          for (int b = 0; b < 4; ++b) {
            gp[a][b][0] = pack2(sigmoidf_(accG[a][b][0] + b0), sigmoidf_(accG[a][b][1] + b1));
            gp[a][b][1] = pack2(sigmoidf_(accG[a][b][2] + b2), sigmoidf_(accG[a][b][3] + b3));
          }
        }
      }
      f32x4 accP[4][4];
#pragma unroll
      for (int a = 0; a < 4; ++a)
#pragma unroll
        for (int b = 0; b < 4; ++b) accP[a][b] = f32x4{0.f, 0.f, 0.f, 0.f};
      gemm_mainloop_sb<128, 128>(pp, opb, opn, accP, smem);
#pragma unroll
      for (int a = 0; a < 4; ++a)
#pragma unroll
        for (int b = 0; b < 4; ++b) {
          pm[a][b][0] = pack2(bflo(pm[a][b][0]) + bflo(gp[a][b][0]) * accP[a][b][0],
                              bfhi(pm[a][b][0]) + bfhi(gp[a][b][0]) * accP[a][b][1]);
          pm[a][b][1] = pack2(bflo(pm[a][b][1]) + bflo(gp[a][b][1]) * accP[a][b][2],
                              bfhi(pm[a][b][1]) + bfhi(gp[a][b][1]) * accP[a][b][3]);
        }
    }
#pragma unroll
    for (int a = 0; a < 4; ++a) {
      const int feat = tn * 128 + wf * 64 + a * 16 + fq * 4;
#pragma unroll
      for (int b = 0; b < 4; ++b) {
        const int tok = tm * 128 + wt * 64 + b * 16 + fr;
        *(uint2*)(merged + (size_t)tok * LDH + feat) = make_uint2(pm[a][b][0], pm[a][b][1]);
      }
    }
  }
}

template <bool MLSTM>
DEV void linattn_item(const Params& p, int layer, int b, int bl, int head, char* smem) {
  const int tid = ltid(), lane = tid & 63, wv = tid >> 6, fr_ = lane & 15, fq_ = lane >> 4;
  const u16* zb = p.zreg + (size_t)bl * 2048 * ZW;
  const int CQ = (MLSTM ? 0 : 3072) + head * 128, CK = (MLSTM ? 512 : 3584) + head * 128,
            CV = (MLSTM ? 1024 : 4096) + head * 128, CO = (MLSTM ? 1536 : 4608) + head * 128;
  char* Qs = smem;
  char* Ks = smem + 16384;
  char* KwT = smem + 32768;
  char* Vt = smem + 49152;
  char* Ps = smem + 65536;
  float* A_al = (float*)(smem + 73728);
  float* A_em = A_al + 64;
  float* A_c = A_em + 64;
  float* A_M = A_c + 64;
  float* A_ws = A_M + 64;
  float* qn = A_ws + 64;
  float* part = qn + 64;
  float* stat = part + 256;
  float* nS = stat + 512;
  float* misc = nS + 128;
  u16* Y = p.br + (size_t)(MLSTM ? 0 : 2) * 32768 * LDB;
  const float* gain = (MLSTM ? p.m_norm : p.r_norm) + layer * 512 + head * 128;
  const float lg2 = MLSTM ? 0.f : log2f(1.f - exp2f(-5.f - (float)head));
  const float KSCALE = 0.08838834764831845f;

  f32x4 accC[2][8];
#pragma unroll
  for (int a = 0; a < 2; ++a)
#pragma unroll
    for (int d = 0; d < 8; ++d) accC[a][d] = f32x4{0.f, 0.f, 0.f, 0.f};
  float nreg = 0.f, mrun = 0.f;
  if (MLSTM && tid < 128) nS[tid] = 0.f;

  const int lrow_ = tid >> 2, cq_ = tid & 3;
  float4 gnv[2];
#pragma unroll
  for (int a = 0; a < 2; ++a) gnv[a] = *(const float4*)(gain + (2 * wv + a) * 16 + fq_ * 4);
  float g_li = 0.f, g_f = 0.f;
  if (MLSTM && wv == 0) {
    const float* sp = p.small + (size_t)(b * 2048 + lane) * 16;
    g_li = sp[head]; g_f = sp[4 + head];
  }
  u32x4 rq[4], rk[4], rv[4];
  {
    const u16* rowp = zb + (size_t)lrow_ * ZW;
#pragma unroll
    for (int i = 0; i < 4; ++i) {
      const int chn = cq_ + (i & 1) * 4 + (i >> 1) * 8;
      rq[i] = *(const u32x4*)(rowp + CQ + chn * 8);
      rk[i] = *(const u32x4*)(rowp + CK + chn * 8);
      rv[i] = *(const u32x4*)(rowp + CV + chn * 8);
    }
  }
  for (int ch = 0; ch < 32; ++ch) {
    const int t0 = ch * 64;
    int fr = fr_, fq = fq_, lrow = lrow_, cq = cq_;
    asm volatile("" : "+v"(fr), "+v"(fq), "+v"(lrow), "+v"(cq));
    if (ch == 0 && wv < 2) {
      const float* qk = p.qk0 + (size_t)b * 2048 + (MLSTM ? 0 : 1024) + head * 128;
      const float pr = qk[tid] * qk[512 + tid];
      const float ws_ = wave_sum(pr);
      if (lane == 0) misc[2 + wv] = ws_;
    }
    if (MLSTM && wv == 0) {
      const float li = g_li, lf = logsigf_(g_f);
      float bcs = lf;
#pragma unroll
      for (int o = 1; o < 64; o <<= 1) { const float t = __shfl_up(bcs, o); if (lane >= o) bcs += t; }
      const float cc = li - bcs;
      float cm = cc;
#pragma unroll
      for (int o = 1; o < 64; o <<= 1) { const float t = __shfl_up(cm, o); if (lane >= o) cm = fmaxf(cm, t); }
      const float Mt = fmaxf(mrun, cm);
      A_c[lane] = cc; A_M[lane] = Mt; A_al[lane] = expf(mrun - Mt); A_em[lane] = expf(-(bcs + Mt));
      const float M63 = __shfl(Mt, 63), g = __shfl(bcs, 63);
      A_ws[lane] = expf(cc - M63);
      if (lane == 0) misc[0] = expf(mrun - M63);
      mrun = g + M63;
    }
    {
      const float beta = MLSTM ? 1.f : fexp2((float)(63 - lrow) * lg2);
      if (!MLSTM) {
        const float posf = (float)p.pos[b * 2048 + t0 + lrow];
#pragma unroll
        for (int pr = 0; pr < 2; ++pr) {
          const int chn = cq + pr * 4;
          u32 q1[4], q2[4], k1[4], k2[4];
#pragma unroll
          for (int w = 0; w < 4; ++w) {
            const u32 q1w = wsel(rq[pr], w), q2w = wsel(rq[pr + 2], w), k1w = wsel(rk[pr], w), k2w = wsel(rk[pr + 2], w);
            const int fi = chn * 8 + w * 2;
            const float rev0 = posf * (exp2f(-(float)fi * (13.287712379549449f / 64.f)) * 0.15915494309189535f);
            const float rev1 = posf * (exp2f(-(float)(fi + 1) * (13.287712379549449f / 64.f)) * 0.15915494309189535f);
            const float f0 = __builtin_amdgcn_fractf(rev0), f1 = __builtin_amdgcn_fractf(rev1);
            const float sn0 = __builtin_amdgcn_sinf(f0), cs0 = __builtin_amdgcn_cosf(f0);
            const float sn1 = __builtin_amdgcn_sinf(f1), cs1 = __builtin_amdgcn_cosf(f1);
            const float qa0 = bflo(q1w), qa1 = bfhi(q1w), qb0 = bflo(q2w), qb1 = bfhi(q2w);
            const float ka0 = bflo(k1w), ka1 = bfhi(k1w), kb0 = bflo(k2w), kb1 = bfhi(k2w);
            q1[w] = pack2(qa0 * cs0 - qb0 * sn0, qa1 * cs1 - qb1 * sn1);
            q2[w] = pack2(qa0 * sn0 + qb0 * cs0, qa1 * sn1 + qb1 * cs1);
            k1[w] = pack2(ka0 * cs0 - kb0 * sn0, ka1 * cs1 - kb1 * sn1);
            k2[w] = pack2(ka0 * sn0 + kb0 * cs0, ka1 * sn1 + kb1 * cs1);
          }
          rq[pr] = u32x4{q1[0], q1[1], q1[2], q1[3]}; rq[pr + 2] = u32x4{q2[0], q2[1], q2[2], q2[3]};
          rk[pr] = u32x4{k1[0], k1[1], k1[2], k1[3]}; rk[pr + 2] = u32x4{k2[0], k2[1], k2[2], k2[3]};
        }
      }
#pragma unroll
      for (int i = 0; i < 4; ++i) {
        const int chn = cq + (i & 1) * 4 + (i >> 1) * 8;
        *(u32x4*)(Qs + sw16(lrow, chn)) = rq[i];
        float kv[8];
#pragma unroll
        for (int w = 0; w < 4; ++w) { kv[2 * w] = bflo(wsel(rk[i], w)) * KSCALE; kv[2 * w + 1] = bfhi(wsel(rk[i], w)) * KSCALE; }
        *(uint4*)(Ks + sw16(lrow, chn)) =
            make_uint4(pack2(kv[0], kv[1]), pack2(kv[2], kv[3]), pack2(kv[4], kv[5]), pack2(kv[6], kv[7]));
#pragma unroll
        for (int e = 0; e < 8; ++e) {
          const int d = chn * 8 + e;
          if (!MLSTM) *(u16*)(KwT + sw8(d, lrow >> 3) + (lrow & 7) * 2) = f2bf(kv[e] * beta);
          const u16 ve = (u16)((wsel(rv[i], e >> 1) >> ((e & 1) * 16)) & 0xffffu);
          *(u16*)(Vt + sw8(d, lrow >> 3) + (lrow & 7) * 2) = ve;
        }
      }
    }
    __syncthreads();
    if (MLSTM) {
      const float beta = A_ws[lrow];
#pragma unroll
      for (int i = 0; i < 4; ++i) {
        const int chn = cq + (i & 1) * 4 + (i >> 1) * 8;
#pragma unroll
        for (int e = 0; e < 8; ++e) {
          const u32 w = wsel(rk[i], e >> 1);
          const float kf = ((e & 1) ? bfhi(w) : bflo(w)) * KSCALE * beta;
          *(u16*)(KwT + sw8(chn * 8 + e, lrow >> 3) + (lrow & 7) * 2) = f2bf(kf);
        }
      }
    }
    uint2 og[4][2];
#pragma unroll
    for (int t = 0; t < 4; ++t)
#pragma unroll
      for (int a = 0; a < 2; ++a)
        og[t][a] = *(const uint2*)(zb + (size_t)(t0 + t * 16 + fr) * ZW + CO + (2 * wv + a) * 16 + fq * 4);
    f32x4 num[2][4];
#pragma unroll
    for (int a = 0; a < 2; ++a)
#pragma unroll
      for (int t = 0; t < 4; ++t) num[a][t] = f32x4{0.f, 0.f, 0.f, 0.f};
#pragma unroll
    for (int pp = 0; pp < 4; ++pp) {
      bf16x8 ca[2];
#pragma unroll
      for (int a = 0; a < 2; ++a)
        ca[a] = mk8(pack2(accC[a][2 * pp][0], accC[a][2 * pp][1]), pack2(accC[a][2 * pp][2], accC[a][2 * pp][3]),
                    pack2(accC[a][2 * pp + 1][0], accC[a][2 * pp + 1][1]), pack2(accC[a][2 * pp + 1][2], accC[a][2 * pp + 1][3]));
#pragma unroll
      for (int t = 0; t < 4; ++t) {
        const int row = t * 16 + fr;
        const uint2 h0 = *(const uint2*)(Qs + sw16(row, 4 * pp + (fq >> 1)) + (fq & 1) * 8);
        const uint2 h1 = *(const uint2*)(Qs + sw16(row, 4 * pp + 2 + (fq >> 1)) + (fq & 1) * 8);
        const bf16x8 qb = mk8(h0.x, h0.y, h1.x, h1.y);
#pragma unroll
        for (int a = 0; a < 2; ++a) num[a][t] = mfma16(ca[a], qb, num[a][t]);
      }
    }
#pragma unroll
    for (int t = 0; t < 4; ++t) {
      const int tt = t * 16 + fr;
      const float al = MLSTM ? A_al[tt] : fexp2((float)(tt + 1) * lg2);
#pragma unroll
      for (int a = 0; a < 2; ++a) { num[a][t][0] *= al; num[a][t][1] *= al; num[a][t][2] *= al; num[a][t][3] *= al; }
    }
    {
      f32x4 sacc[4];
#pragma unroll
      for (int t = 0; t < 4; ++t) sacc[t] = f32x4{0.f, 0.f, 0.f, 0.f};
#pragma unroll
      for (int ks = 0; ks < 4; ++ks) {
        const bf16x8 kf = lds128(Ks + sw16(wv * 16 + fr, ks * 4 + fq));
#pragma unroll
        for (int t = 0; t < 4; ++t) sacc[t] = mfma16(kf, lds128(Qs + sw16(t * 16 + fr, ks * 4 + fq)), sacc[t]);
      }
      if (ch == 0 && wv == 0 && lane == 0) sacc[0][0] = (misc[2] + misc[3]) * KSCALE;
      const int s0 = wv * 16 + fq * 4;
      float cs4[4];
      if (MLSTM) {
#pragma unroll
        for (int j = 0; j < 4; ++j) cs4[j] = A_c[s0 + j];
      }
#pragma unroll
      for (int t = 0; t < 4; ++t) {
        const int tt = t * 16 + fr;
        const float Mt = MLSTM ? A_M[tt] : 0.f;
        float pv[4];
#pragma unroll
        for (int j = 0; j < 4; ++j) {
          const int s = s0 + j;
          float dm;
          if (MLSTM) dm = fexp(cs4[j] - Mt); else dm = fexp2((float)(tt - s) * lg2);
          pv[j] = (s <= tt) ? sacc[t][j] * dm : 0.f;
        }
        if (MLSTM) {
          float ps = pv[0] + pv[1] + pv[2] + pv[3];
          ps += __shfl_xor(ps, 16);
          ps += __shfl_xor(ps, 32);
          if (fq == 0) part[wv * 64 + tt] = ps;
        }
        *(uint2*)(Ps + sw8(tt, wv * 2 + (fq >> 1)) + (fq & 1) * 8) = make_uint2(pack2(pv[0], pv[1]), pack2(pv[2], pv[3]));
      }
    }
    if (MLSTM) {
      const int tt = tid >> 2, qt = tid & 3;
      float s = 0.f;
#pragma unroll
      for (int i = 0; i < 4; ++i) {
        const u32x4 qf = *(const u32x4*)(Qs + sw16(tt, qt * 4 + i));
        const float* np = nS + (qt * 4 + i) * 8;
#pragma unroll
        for (int w = 0; w < 4; ++w) s += bflo(wsel(qf, w)) * np[2 * w] + bfhi(wsel(qf, w)) * np[2 * w + 1];
      }
      s += __shfl_xor(s, 1);
      s += __shfl_xor(s, 2);
      if (qt == 0) qn[tt] = s;
    }
    __syncthreads();
    {
      bf16x8 vf[2][2];
#pragma unroll
      for (int a = 0; a < 2; ++a)
#pragma unroll
        for (int ks = 0; ks < 2; ++ks) vf[a][ks] = lds128(Vt + sw8((2 * wv + a) * 16 + fr, ks * 4 + fq));
#pragma unroll
      for (int t = 0; t < 4; ++t)
#pragma unroll
        for (int ks = 0; ks < 2; ++ks) {
          const bf16x8 pf = lds128(Ps + sw8(t * 16 + fr, ks * 4 + fq));
#pragma unroll
          for (int a = 0; a < 2; ++a) num[a][t] = mfma16(vf[a][ks], pf, num[a][t]);
        }
      const float delta = MLSTM ? misc[0] : fexp2(64.f * lg2);
#pragma unroll
      for (int d = 0; d < 8; ++d) {
#pragma unroll
        for (int a = 0; a < 2; ++a) { accC[a][d][0] *= delta; accC[a][d][1] *= delta; accC[a][d][2] *= delta; accC[a][d][3] *= delta; }
#pragma unroll
        for (int ks = 0; ks < 2; ++ks) {
          const bf16x8 kwf = lds128(KwT + sw8(d * 16 + fr, ks * 4 + fq));
#pragma unroll
          for (int a = 0; a < 2; ++a) accC[a][d] = mfma16(kwf, vf[a][ks], accC[a][d]);
        }
      }
      if (MLSTM && tid < 128) {
        float s = 0.f;
#pragma unroll
        for (int i = 0; i < 8; ++i) {
          const u32x4 kf = *(const u32x4*)(KwT + tid * 128 + i * 16);
#pragma unroll
          for (int w = 0; w < 4; ++w) s += bflo(wsel(kf, w)) + bfhi(wsel(kf, w));
        }
        nreg = delta * nreg + s;
        nS[tid] = nreg;
      }
    }
#pragma unroll
    for (int t = 0; t < 4; ++t) {
      const int tt = t * 16 + fr;
      float s1 = 0.f, s2 = 0.f;
      float rden = 1.f;
      if (MLSTM) {
        const float den = A_al[tt] * qn[tt] + part[tt] + part[64 + tt] + part[128 + tt] + part[192 + tt];
        rden = frcp(fmaxf(fabsf(den), A_em[tt]));
      }
#pragma unroll
      for (int a = 0; a < 2; ++a) {
        if (MLSTM) {
          const uint2 ov = og[t][a];
          num[a][t][0] *= rden * sigmoidf_(bflo(ov.x));
          num[a][t][1] *= rden * sigmoidf_(bfhi(ov.x));
          num[a][t][2] *= rden * sigmoidf_(bflo(ov.y));
          num[a][t][3] *= rden * sigmoidf_(bfhi(ov.y));
        }
#pragma unroll
        for (int j = 0; j < 4; ++j) { s1 += num[a][t][j]; s2 += num[a][t][j] * num[a][t][j]; }
      }
      s1 += __shfl_xor(s1, 16); s1 += __shfl_xor(s1, 32);
      s2 += __shfl_xor(s2, 16); s2 += __shfl_xor(s2, 32);
      if (fq == 0) { stat[(wv * 64 + tt) * 2] = s1; stat[(wv * 64 + tt) * 2 + 1] = s2; }
    }
    __syncthreads();
    {
      const int tn_ = (ch + 1 < 32) ? t0 + 64 : t0;
      if (MLSTM && wv == 0) {
        const float* sp = p.small + (size_t)(b * 2048 + tn_ + lane) * 16;
        g_li = sp[head]; g_f = sp[4 + head];
      }
      const u16* rowp = zb + (size_t)(tn_ + lrow) * ZW;
#pragma unroll
      for (int i = 0; i < 4; ++i) {
        const int chn = cq + (i & 1) * 4 + (i >> 1) * 8;
        rq[i] = *(const u32x4*)(rowp + CQ + chn * 8);
        rk[i] = *(const u32x4*)(rowp + CK + chn * 8);
        rv[i] = *(const u32x4*)(rowp + CV + chn * 8);
      }
    }
#pragma unroll
    for (int t = 0; t < 4; ++t) {
      const int tt = t * 16 + fr;
      float s1 = 0.f, s2 = 0.f;
#pragma unroll
      for (int w = 0; w < 4; ++w) { s1 += stat[(w * 64 + tt) * 2]; s2 += stat[(w * 64 + tt) * 2 + 1]; }
      const float mean = s1 * (1.f / 128.f);
      const float var = fmaxf(s2 * (1.f / 128.f) - mean * mean, 0.f);
      const float rstd = rsqrtf(var + 1e-5f);
#pragma unroll
      for (int a = 0; a < 2; ++a) {
        const int e0 = (2 * wv + a) * 16 + fq * 4;
        const float4 gn = gnv[a];
        float o0 = (num[a][t][0] - mean) * rstd * gn.x, o1 = (num[a][t][1] - mean) * rstd * gn.y;
        float o2 = (num[a][t][2] - mean) * rstd * gn.z, o3 = (num[a][t][3] - mean) * rstd * gn.w;
        if (!MLSTM) {
          const uint2 gv = og[t][a];
          const float g0 = bflo(gv.x), g1 = bfhi(gv.x), g2 = bflo(gv.y), g3 = bfhi(gv.y);
          o0 *= g0 * sigmoidf_(g0); o1 *= g1 * sigmoidf_(g1); o2 *= g2 * sigmoidf_(g2); o3 *= g3 * sigmoidf_(g3);
        }
        *(uint2*)(Y + (size_t)(b * 2048 + t0 + tt) * LDB + head * 128 + e0) = make_uint2(pack2(o0, o1), pack2(o2, o3));
      }
    }
  }
  __syncthreads();
}

DEV void attn_item(const Params& p, int b, int bl, int head, int qb, char* smem) {
  const int tid = ltid(), lane = tid & 63, wv = tid >> 6, fr = lane & 15, fq = lane >> 4;
  const u16* zb = p.zreg + (size_t)bl * 2048 * ZW;
  const int CQ = 5120 + head * 128, CK = 5632 + head * 128, CV = 6144 + head * 128;
  char* Ks = smem;
  char* Vt = smem + 16384;
  float* F = (float*)(smem + 32768);
  float* wtot = (float*)(smem + 40960);
  const int lo = qb * 128, hi = lo + 128;
  {
    const int s0 = tid * 8;
    float v[8];
    float run = 0.f;
#pragma unroll
    for (int i = 0; i < 8; ++i) {
      float lf = 0.f;
      if (s0 < hi) lf = logsigf_(p.small[(size_t)(b * 2048 + s0 + i) * 16 + 8 + head]);
      run += lf; v[i] = run;
    }
    float incl = run;
#pragma unroll
    for (int o = 1; o < 64; o <<= 1) { const float t = __shfl_up(incl, o); if (lane >= o) incl += t; }
    if (lane == 63) wtot[wv] = incl;
    __syncthreads();
    float off = incl - run;
    for (int w = 0; w < wv; ++w) off += wtot[w];
#pragma unroll
    for (int i = 0; i < 8; ++i) F[s0 + i] = (off + v[i]) * LOG2E;
  }
  bf16x8 qf[2][4];
  const int qrow0 = lo + wv * 32;
#pragma unroll
  for (int qi = 0; qi < 2; ++qi)
#pragma unroll
    for (int ks = 0; ks < 4; ++ks)
      qf[qi][ks] = *(const bf16x8*)(zb + (size_t)(qrow0 + qi * 16 + fr) * ZW + CQ + ks * 32 + fq * 8);
  __syncthreads();
  float Fq[2], mrow[2], lrow[2];
#pragma unroll
  for (int qi = 0; qi < 2; ++qi) { Fq[qi] = F[qrow0 + qi * 16 + fr]; mrow[qi] = -INFINITY; lrow[qi] = 0.f; }
  f32x4 o[8][2];
#pragma unroll
  for (int e = 0; e < 8; ++e)
#pragma unroll
    for (int qi = 0; qi < 2; ++qi) o[e][qi] = f32x4{0.f, 0.f, 0.f, 0.f};
  const float SC = 0.08838834764831845f * LOG2E;
  const int nkt = (qb + 1) * 2;
  const int krow = tid >> 2, kc = tid & 3;
  u32x4 rk[4], rv[4];
  {
    const u16* rp = zb + (size_t)krow * ZW;
#pragma unroll
    for (int i = 0; i < 4; ++i) { rk[i] = *(const u32x4*)(rp + CK + (kc + i * 4) * 8); rv[i] = *(const u32x4*)(rp + CV + (kc + i * 4) * 8); }
  }
  for (int kt = 0; kt < nkt; ++kt) {
    __syncthreads();
#pragma unroll
    for (int i = 0; i < 4; ++i) {
      const int chn = kc + i * 4;
      *(u32x4*)(Ks + sw16(krow, chn)) = rk[i];
#pragma unroll
      for (int e = 0; e < 8; ++e) {
        const u16 ve = (u16)((wsel(rv[i], e >> 1) >> ((e & 1) * 16)) & 0xffffu);
        *(u16*)(Vt + sw8(chn * 8 + e, krow >> 3) + (krow & 7) * 2) = ve;
      }
    }
    __syncthreads();
    const int key0 = kt * 64;
    const bool active = (key0 <= qrow0 + 31);
    bf16x8 pb[2][2];
    if (active) {
      f32x4 s[4][2];
#pragma unroll
      for (int a = 0; a < 4; ++a)
#pragma unroll
        for (int qi = 0; qi < 2; ++qi) s[a][qi] = f32x4{0.f, 0.f, 0.f, 0.f};
#pragma unroll
      for (int ks = 0; ks < 4; ++ks)
#pragma unroll
        for (int a = 0; a < 4; ++a) {
          const bf16x8 kf = lds128(Ks + sw16(a * 16 + fr, ks * 4 + fq));
#pragma unroll
          for (int qi = 0; qi < 2; ++qi) s[a][qi] = mfma16(kf, qf[qi][ks], s[a][qi]);
        }
      const bool need_mask = (key0 + 63 > qrow0);
      float mx[2] = {-INFINITY, -INFINITY};
#pragma unroll
      for (int a = 0; a < 4; ++a) {
        const float4 fk = *(const float4*)(F + key0 + a * 16 + fq * 4);
#pragma unroll
        for (int qi = 0; qi < 2; ++qi) {
          const int qpos = qrow0 + qi * 16 + fr;
#pragma unroll
          for (int j = 0; j < 4; ++j) {
            float xv = s[a][qi][j] * SC + Fq[qi] - (j == 0 ? fk.x : (j == 1 ? fk.y : (j == 2 ? fk.z : fk.w)));
            if (need_mask && (key0 + a * 16 + fq * 4 + j > qpos)) xv = -INFINITY;
            s[a][qi][j] = xv;
            mx[qi] = fmaxf(mx[qi], xv);
          }
        }
      }
#pragma unroll
      for (int qi = 0; qi < 2; ++qi) {
        float m = mx[qi];
        m = fmaxf(m, __shfl_xor(m, 16));
        m = fmaxf(m, __shfl_xor(m, 32));
        const float mnew = fmaxf(mrow[qi], m);
        const float alpha = fexp2(mrow[qi] - mnew);
        mrow[qi] = mnew;
        float rs = 0.f;
#pragma unroll
        for (int a = 0; a < 4; ++a)
#pragma unroll
          for (int j = 0; j < 4; ++j) { const float pv = fexp2(s[a][qi][j] - mnew); s[a][qi][j] = pv; rs += pv; }
        rs += __shfl_xor(rs, 16);
        rs += __shfl_xor(rs, 32);
        lrow[qi] = lrow[qi] * alpha + rs;
#pragma unroll
        for (int e = 0; e < 8; ++e) { o[e][qi][0] *= alpha; o[e][qi][1] *= alpha; o[e][qi][2] *= alpha; o[e][qi][3] *= alpha; }
#pragma unroll
        for (int pp = 0; pp < 2; ++pp) {
          pb[qi][pp] = mk8(pack2(s[2 * pp][qi][0], s[2 * pp][qi][1]), pack2(s[2 * pp][qi][2], s[2 * pp][qi][3]),
                           pack2(s[2 * pp + 1][qi][0], s[2 * pp + 1][qi][1]), pack2(s[2 * pp + 1][qi][2], s[2 * pp + 1][qi][3]));
        }
      }
    }
    if (kt + 1 < nkt) {
      const u16* rp = zb + (size_t)((kt + 1) * 64 + krow) * ZW;
#pragma unroll
      for (int i = 0; i < 4; ++i) { rk[i] = *(const u32x4*)(rp + CK + (kc + i * 4) * 8); rv[i] = *(const u32x4*)(rp + CV + (kc + i * 4) * 8); }
    }
    if (active) {
#pragma unroll
      for (int pp = 0; pp < 2; ++pp)
#pragma unroll
        for (int e = 0; e < 8; ++e) {
          const int row = e * 16 + fr;
          const uint2 h0 = *(const uint2*)(Vt + sw8(row, 4 * pp + (fq >> 1)) + (fq & 1) * 8);
          const uint2 h1 = *(const uint2*)(Vt + sw8(row, 4 * pp + 2 + (fq >> 1)) + (fq & 1) * 8);
          const bf16x8 va = mk8(h0.x, h0.y, h1.x, h1.y);
#pragma unroll
          for (int qi = 0; qi < 2; ++qi) o[e][qi] = mfma16(va, pb[qi][pp], o[e][qi]);
        }
    }
  }
  u16* Y = p.br + (size_t)3 * 32768 * LDB;
#pragma unroll
  for (int qi = 0; qi < 2; ++qi) {
    const float rl = 1.f / lrow[qi];
    const int tok = b * 2048 + qrow0 + qi * 16 + fr;
#pragma unroll
    for (int e = 0; e < 8; ++e) {
      *(uint2*)(Y + (size_t)tok * LDB + head * 128 + e * 16 + fq * 4) =
          make_uint2(pack2(o[e][qi][0] * rl, o[e][qi][1] * rl), pack2(o[e][qi][2] * rl, o[e][qi][3] * rl));
    }
  }
  __syncthreads();
}

DEV void lru_item(const Params& p, int layer, int b, int bl, int n, int eh, char* smem) {
  const int tid = ltid(), lane = tid & 63, wv = tid >> 6, fr = lane & 15, fq = lane >> 4;
  const u16* zb = p.zreg + (size_t)bl * 2048 * ZW;
  const int CX = 2048 + n * 64, CG = 2560 + n * 64 + eh * 32;
  char* WaT = smem;
  char* WxT = smem + 4096;
  char* XcB = smem + 8192;
  float* XcF = (float*)(smem + 16384);
  float* aS = (float*)(smem + 24576);
  float* segP = (float*)(smem + 32768);
  float* segH = segP + 256;
  u16* Y = p.br + (size_t)1 * 32768 * LDB;
  {
    const float* wa = p.lru_wa + ((size_t)layer * 8 + n) * 4096;
    const float* wx = p.lru_wx + ((size_t)layer * 8 + n) * 4096;
    for (int i = tid; i < 2048; i += 256) {
      const int d = i >> 5, e = i & 31;
      *(u16*)(WaT + sw8(e, d >> 3) + (d & 7) * 2) = f2bf(wa[d * 64 + eh * 32 + e]);
      *(u16*)(WxT + sw8(e, d >> 3) + (d & 7) * 2) = f2bf(wx[d * 64 + eh * 32 + e]);
    }
  }
  const int c = tid & 63, sg = tid >> 6;
  const int chb = layer * 512 + n * 64;
  const float cw0 = p.conv_w[(layer * 4 + 0) * 512 + n * 64 + c], cw1 = p.conv_w[(layer * 4 + 1) * 512 + n * 64 + c],
              cw2 = p.conv_w[(layer * 4 + 2) * 512 + n * 64 + c], cw3 = p.conv_w[(layer * 4 + 3) * 512 + n * 64 + c];
  const float cb = p.conv_b[chb + c];
  const int esub = wv & 1, tp = wv >> 1;
  float ba[4], bx[4], spl[4];
#pragma unroll
  for (int j = 0; j < 4; ++j) {
    const int e = chb + eh * 32 + esub * 16 + fq * 4 + j;
    ba[j] = p.lru_ba[e]; bx[j] = p.lru_bx[e];
    const float lam = p.lru_lam[e];
    spl[j] = fmaxf(-lam, 0.f) + log1pf(expf(-fabsf(lam)));
  }
  const int sc = tid & 31, ss = tid >> 5;
  float carry = 0.f;
  for (int chk = 0; chk < 32; ++chk) {
    const int t0 = chk * 64;
    {
      float xm3 = 0.f, xm2 = 0.f, xm1 = 0.f;
      const int tb = t0 + sg * 16;
      if (tb >= 3) {
        xm3 = bf2f(zb[(size_t)(tb - 3) * ZW + CX + c]);
        xm2 = bf2f(zb[(size_t)(tb - 2) * ZW + CX + c]);
        xm1 = bf2f(zb[(size_t)(tb - 1) * ZW + CX + c]);
      }
      float xin[16];
#pragma unroll
      for (int i = 0; i < 16; ++i) xin[i] = bf2f(zb[(size_t)(tb + i) * ZW + CX + c]);
#pragma unroll
      for (int i = 0; i < 16; ++i) {
        const float x0 = xin[i];
        const float xc = cb + cw0 * xm3 + cw1 * xm2 + cw2 * xm1 + cw3 * x0;
        xm3 = xm2; xm2 = xm1; xm1 = x0;
        const int tok = sg * 16 + i;
        if ((c >> 5) == eh) XcF[tok * 32 + (c & 31)] = xc;
        *(u16*)(XcB + sw8(tok, c >> 3) + (c & 7) * 2) = f2bf(xc);
      }
    }
    __syncthreads();
    {
      f32x4 ga[2], gx[2];
#pragma unroll
      for (int t = 0; t < 2; ++t) { ga[t] = f32x4{0.f, 0.f, 0.f, 0.f}; gx[t] = f32x4{0.f, 0.f, 0.f, 0.f}; }
#pragma unroll
      for (int ks = 0; ks < 2; ++ks) {
        const bf16x8 af = lds128(WaT + sw8(esub * 16 + fr, ks * 4 + fq));
        const bf16x8 xf = lds128(WxT + sw8(esub * 16 + fr, ks * 4 + fq));
#pragma unroll
        for (int t = 0; t < 2; ++t) {
          const bf16x8 tf = lds128(XcB + sw8((tp * 2 + t) * 16 + fr, ks * 4 + fq));
          ga[t] = mfma16(af, tf, ga[t]);
          gx[t] = mfma16(xf, tf, gx[t]);
        }
      }
#pragma unroll
      for (int t = 0; t < 2; ++t) {
        const int tok = (tp * 2 + t) * 16 + fr;
#pragma unroll
        for (int j = 0; j < 4; ++j) {
          const int e = esub * 16 + fq * 4 + j;
          const float r = sigmoidf_(ga[t][j] + ba[j]);
          const float ig = sigmoidf_(gx[t][j] + bx[j]);
          const float la = -8.f * r * spl[j];
          const float a = fexp(la);
          const float u = sqrtf(fmaxf(-expm1f(2.f * la), 0.f)) * ig * XcF[tok * 32 + e];
          aS[tok * 32 + e] = a;
          XcF[tok * 32 + e] = u;
        }
      }
    }
    __syncthreads();
    {
      float hl[8], pc[8];
      float hh = 0.f, pp = 1.f;
#pragma unroll
      for (int i = 0; i < 8; ++i) {
        const int tok = ss * 8 + i;
        const float a = aS[tok * 32 + sc], u = XcF[tok * 32 + sc];
        hh = a * hh + u; pp *= a;
        hl[i] = hh; pc[i] = pp;
      }
      segP[ss * 32 + sc] = pp; segH[ss * 32 + sc] = hh;
      float gte[8];
#pragma unroll
      for (int i = 0; i < 8; ++i) gte[i] = bf2f(zb[(size_t)(t0 + ss * 8 + i) * ZW + CG + sc]);
      __syncthreads();
      float cin = carry, call = carry;
#pragma unroll
      for (int s = 0; s < 8; ++s) {
        call = segP[s * 32 + sc] * call + segH[s * 32 + sc];
        if (s + 1 == ss) cin = call;
      }
      carry = call;
#pragma unroll
      for (int i = 0; i < 8; ++i) {
        const int t = t0 + ss * 8 + i;
        const float hv = hl[i] + pc[i] * cin;
        const float g = gte[i];
        const float ge = g * sigmoidf_(1.5957691216057308f * (g + 0.044715f * g * g * g));
        Y[(size_t)(b * 2048 + t) * LDB + n * 64 + eh * 32 + sc] = f2bf(hv * ge);
      }
    }
    __syncthreads();
  }
}

DEV void phase_branches(const Params& p, int layer, int half, char* smem) {
  unsigned* ctr = p.bar + 4 + 64 * (layer * 2 + half);
  int* s_item = (int*)(smem + SMEM_BYTES - 16);
  const int bid = blockIdx.x;
  for (int it = bid; it < 64; it += gridDim.x) {
    const int k = it & 31, bl = k >> 2, head = k & 3;
    if (it < 32) linattn_item<true>(p, layer, half * 8 + bl, bl, head, smem);
    else linattn_item<false>(p, layer, half * 8 + bl, bl, head, smem);
  }
  for (;;) {
    if (threadIdx.x == 0) *s_item = (int)atomicAdd(ctr, 1u) + 64;
    __syncthreads();
    const int it = *s_item;
    __syncthreads();
    if (it >= 704) break;
    if (it < 192) {
      const int idx = it - 64, bl = idx >> 4, n = (idx >> 1) & 7, eh = idx & 1;
      lru_item(p, layer, half * 8 + bl, bl, n, eh, smem);
    } else {
      const int idx = it - 192;
      const int qb = 15 - (idx >> 5), bh = idx & 31, bl = bh >> 2, head = bh & 3;
      attn_item(p, half * 8 + bl, bl, head, qb, smem);
    }
  }
}

constexpr int PH_PER_LAYER = 10;
constexpr int N_PHASES = 2 + 2 * PH_PER_LAYER;

DEV void run_phase(const Params& p, int ph, char* smem) {
  if (ph == 0) { phase_prep(p, smem); return; }
  if (ph == 1) { phase_lnmod0(p); return; }
  const int layer = (ph - 2) / PH_PER_LAYER, q = (ph - 2) % PH_PER_LAYER;
  const u16* W = p.Wb + (size_t)layer * WL;
  u16* merged = p.zreg;
  u16* ybuf = p.zreg + (size_t)32768 * LDH;
  u16* ubuf = p.zreg;
  u16* y2buf = p.zreg + (size_t)32768 * LDU;
  switch (q) {
    case 0: phase_zgemm(p, layer, 0, smem); break;
    case 1: phase_branches(p, layer, 0, smem); break;
    case 2: phase_zgemm(p, layer, 1, smem); break;
    case 3: phase_branches(p, layer, 1, smem); break;
    case 4: phase_merge(p, layer, merged, smem); break;
    case 5: phase_gemm<0>(W + OFF_WOUT, LDW1, merged, LDH, p.b_out + layer * 1024, ybuf, LDH, 1024, 1024, smem); break;
    case 6: phase_lnres(p, layer == 0 ? p.x : p.out, ybuf, layer, 0); break;
    case 7: phase_gemm<1>(W + OFF_W1, LDW1, p.h, LDH, p.b_ff1 + layer * 4096, ubuf, LDU, 4096, 1024, smem); break;
    case 8: phase_gemm<0>(W + OFF_W2, LDW4, ubuf, LDU, p.b_ff2 + layer * 1024, y2buf, LDH, 1024, 4096, smem); break;
    case 9: phase_lnres(p, p.out, y2buf, layer, 1); break;
  }
}

#define XB_XCNT(j)  (256  + 64 * (j))
#define XB_XSUB(j)  (1280 + 64 * (j))
#define XB_XGEN(j)  (2304 + 64 * (j))
#define XB_TOP      3328
#define XB_TOPGEN   3392
#define XCD_BAR_WORDS 3456
#define LAS __attribute__((address_space(3)))
DEV unsigned xb_ld(unsigned* p) { return __hip_atomic_load(p, __ATOMIC_RELAXED, __HIP_MEMORY_SCOPE_AGENT); }
DEV unsigned xb_add(unsigned* p, unsigned v) { return __hip_atomic_fetch_add(p, v, __ATOMIC_RELAXED, __HIP_MEMORY_SCOPE_AGENT); }
DEV unsigned xb_xcc_id() { return (unsigned)__builtin_amdgcn_s_getreg((3 << 11) | 20) & 0xFu; }

DEV void xcd_census(unsigned* bar, unsigned x, unsigned& nloc, unsigned& nx) {
  const unsigned G = gridDim.x;
  unsigned sum, cnt, mine;
  for (;;) {
    sum = 0u; cnt = 0u; mine = 0u;
#pragma unroll
    for (unsigned j = 0; j < 16; ++j) {
      const unsigned c = xb_ld(&bar[XB_XCNT(j)]);
      sum += c; cnt += (c > 0u) ? 1u : 0u; mine = (j == x) ? c : mine;
    }
    if (sum == G) break;
    __builtin_amdgcn_s_sleep(1);
  }
  nloc = mine > 0u ? mine : 1u; nx = cnt > 0u ? cnt : 1u;
}

DEV void xcd_barrier(unsigned* bar, unsigned x, volatile unsigned* st) {
  asm volatile("s_waitcnt vmcnt(0)" ::: "memory");
  __syncthreads();
  if (threadIdx.x == 0) {
    __builtin_amdgcn_s_waitcnt(0);
    unsigned nloc = st[0], nx = st[1];
    if (nloc == 0u) { xcd_census(bar, x, nloc, nx); st[0] = nloc; st[1] = nx; }
    const unsigned old = xb_add(&bar[XB_XSUB(x)], 1u);
    const unsigned gen = old / nloc;
    if (old + 1u == (gen + 1u) * nloc) {
      __builtin_amdgcn_fence(__ATOMIC_RELEASE, "agent");
      asm volatile("s_waitcnt vmcnt(0)" ::: "memory");
      const unsigned og = xb_add(&bar[XB_TOP], 1u);
      const unsigned tg = og / nx;
      if (og + 1u == (tg + 1u) * nx) xb_add(&bar[XB_TOPGEN], 1u);
      else { while (xb_ld(&bar[XB_TOPGEN]) == tg) __builtin_amdgcn_s_sleep(1); }
      __builtin_amdgcn_fence(__ATOMIC_ACQUIRE, "agent");
      xb_add(&bar[XB_XGEN(x)], 1u);
      asm volatile("s_waitcnt vmcnt(0)" ::: "memory");
    } else {
      while (xb_ld(&bar[XB_XGEN(x)]) == gen) __builtin_amdgcn_s_sleep(1);
      __builtin_amdgcn_fence(__ATOMIC_ACQUIRE, "agent");
      asm volatile("s_waitcnt vmcnt(0)" ::: "memory");
    }
  }
  __syncthreads();
}

#if MULTI_LAUNCH
__global__ void __launch_bounds__(256, 2) phase_kernel(Params p, int ph) {
  __shared__ __attribute__((aligned(16))) char smem[SMEM_BYTES];
  run_phase(p, ph, smem);
}
#else
__global__ void __launch_bounds__(256, 2) fwd_megakernel(Params p) {
  __shared__ __attribute__((aligned(16))) char smem[SMEM_BYTES];
  volatile unsigned* st = (volatile unsigned*)(smem + SMEM_BYTES - 32);
  const unsigned xcc = xb_xcc_id();
  if (threadIdx.x == 0) { st[0] = 0u; st[1] = 0u; (void)xb_add(&p.bar[XB_XCNT(xcc)], 1u); }
  __syncthreads();
  if (p.bar == nullptr) cg::this_grid().sync();
#define PH(n) run_phase(p, n, smem); xcd_barrier(p.bar, xcc, st);
  PH(0)
  PH(1) PH(2) PH(3) PH(4) PH(5) PH(6) PH(7) PH(8) PH(9) PH(10) PH(11)
  PH(12) PH(13) PH(14) PH(15) PH(16) PH(17) PH(18) PH(19) PH(20)
  run_phase(p, 21, smem);
#undef PH
}
#endif

extern "C" void kernel_launch(void* const* d_in, const int* in_sizes, int n_in, void* d_out, int out_size, void* d_ws,
                              size_t ws_size, hipStream_t stream) {
  Params p{};
  p.x = (const float*)d_in[0]; p.c = (const float*)d_in[1]; p.pos = (const int*)d_in[2];
  p.w_ada = (const float*)d_in[3]; p.b_ada = (const float*)d_in[4]; p.w_in = (const float*)d_in[5];
  p.b_in = (const float*)d_in[6]; p.m_norm = (const float*)d_in[7]; p.conv_w = (const float*)d_in[8];
  p.conv_b = (const float*)d_in[9]; p.lru_wa = (const float*)d_in[10]; p.lru_ba = (const float*)d_in[11];
  p.lru_wx = (const float*)d_in[12]; p.lru_bx = (const float*)d_in[13]; p.lru_lam = (const float*)d_in[14];
  p.r_norm = (const float*)d_in[15]; p.w_br = (const float*)d_in[16]; p.w_out = (const float*)d_in[17];
  p.b_out = (const float*)d_in[18]; p.ln1_g = (const float*)d_in[19]; p.ln1_b = (const float*)d_in[20];
  p.w_ff1 = (const float*)d_in[21]; p.b_ff1 = (const float*)d_in[22]; p.w_ff2 = (const float*)d_in[23];
  p.b_ff2 = (const float*)d_in[24]; p.ln2_g = (const float*)d_in[25]; p.ln2_b = (const float*)d_in[26];
  p.out = (float*)d_out;
  char* ws = (char*)d_ws;
  size_t off = 0;
  p.Wb = (u16*)(ws + off); off += 2 * WL * 2;
  p.h = (u16*)(ws + off); off += (size_t)32768 * LDH * 2;
  p.zreg = (u16*)(ws + off); off += (size_t)16384 * ZW * 2;
  p.br = (u16*)(ws + off); off += (size_t)4 * 32768 * LDB * 2;
  p.small = (float*)(ws + off); off += (size_t)32768 * 16 * 4;
  p.mod = (float*)(ws + off); off += (size_t)2 * 16 * 6144 * 4;
  p.h0f = (float*)(ws + off); off += (size_t)16 * 1024 * 4;
  p.qk0 = (float*)(ws + off); off += (size_t)16 * 2048 * 4;
  p.bar = (unsigned*)(ws + off); off += XCD_BAR_WORDS * 4;
  hipMemsetAsync(p.bar, 0, XCD_BAR_WORDS * 4, stream);
  static int grid_blocks = 0;
  if (!grid_blocks) {
    int dev = 0, cus = 0, per_cu = 0;
    hipGetDevice(&dev);
    hipDeviceGetAttribute(&cus, hipDeviceAttributeMultiprocessorCount, dev);
#if MULTI_LAUNCH
    hipOccupancyMaxActiveBlocksPerMultiprocessor(&per_cu, phase_kernel, 256, 0);
#else
    hipOccupancyMaxActiveBlocksPerMultiprocessor(&per_cu, fwd_megakernel, 256, 0);
#endif
    if (per_cu < 1) per_cu = 1;
    if (per_cu > 2) per_cu = 2;
    grid_blocks = cus * per_cu;
  }
#if MULTI_LAUNCH
  for (int ph = 0; ph < N_PHASES; ++ph) hipLaunchKernelGGL(phase_kernel, dim3(grid_blocks), dim3(256), 0, stream, p, ph);
#else
  void* args[] = {&p};
  hipError_t e = hipLaunchCooperativeKernel((void*)fwd_megakernel, dim3(grid_blocks), dim3(256), args, 0, stream);
  if (e != hipSuccess) fprintf(stderr, "cooperative launch failed: %s (grid %d)\n", hipGetErrorString(e), grid_blocks);
#endif
}
```

```cpp
#include <hip/hip_runtime.h>
#include <hip/hip_cooperative_groups.h>
#include <cstdio>
namespace cg = cooperative_groups;

typedef unsigned short u16;
typedef unsigned int u32;
typedef __attribute__((ext_vector_type(8))) short bf16x8;
typedef __attribute__((ext_vector_type(4))) float f32x4;

#define DEV __device__ __forceinline__
__device__ __forceinline__ int threadIdx_x_raw() { return (int)threadIdx.x; }

#ifndef MULTI_LAUNCH
#define MULTI_LAUNCH 0
#endif

constexpr int SMEM_BYTES = 80384;
constexpr int BF = 256, BTK = 128;
constexpr int ZW = 6720;
constexpr int LDH = 1088;
constexpr int LDU = 4160;
constexpr int LDB = 544;
constexpr int LDW1 = 1088, LDW5 = 544, LDW4 = 4160;
constexpr int NIN = 10764;
constexpr int GATE_ROW0 = 6784;
constexpr size_t OFF_WIN = 0, OFF_WBR = OFF_WIN + (size_t)10880 * LDW1, OFF_WOUT = OFF_WBR + (size_t)4 * 1024 * LDW5,
                 OFF_W1 = OFF_WOUT + (size_t)1024 * LDW1, OFF_W2 = OFF_W1 + (size_t)4096 * LDW1,
                 WL = OFF_W2 + (size_t)1024 * LDW4;
constexpr float ALPHA = 1.4142135623730951f;
constexpr float LOG2E = 1.4426950408889634f;

struct Params {
  const float *x, *c; const int* pos;
  const float *w_ada, *b_ada, *w_in, *b_in, *m_norm, *conv_w, *conv_b, *lru_wa, *lru_ba, *lru_wx, *lru_bx, *lru_lam,
      *r_norm, *w_br, *w_out, *b_out, *ln1_g, *ln1_b, *w_ff1, *b_ff1, *w_ff2, *b_ff2, *ln2_g, *ln2_b;
  float* out;
  u16* Wb; u16* h; u16* zreg; u16* br; float* small; float* mod; float* h0f; float* qk0; unsigned* bar;
};

typedef __attribute__((ext_vector_type(4))) unsigned int u32x4;
DEV bf16x8 mk8(u32 a, u32 b, u32 c, u32 d) { u32x4 t = {a, b, c, d}; return __builtin_bit_cast(bf16x8, t); }
DEV u32 wsel(u32x4 q, int i) { return q[i]; }

DEV int ltid() { int t = threadIdx_x_raw(); asm volatile("" : "+v"(t)); return t; }
typedef __attribute__((ext_vector_type(2))) __bf16 bf16v2;
typedef __attribute__((ext_vector_type(2))) float f32v2;
DEV u32 pack2(float a, float b) { f32v2 v = {a, b}; return __builtin_bit_cast(u32, __builtin_convertvector(v, bf16v2)); }
DEV u16 f2bf(float f) { return (u16)(pack2(f, 0.f) & 0xffffu); }
DEV float bf2f(u32 h) { return __uint_as_float(h << 16); }
DEV float bflo(u32 w) { return __uint_as_float(w << 16); }
DEV float bfhi(u32 w) { return __uint_as_float(w & 0xffff0000u); }
DEV f32x4 mfma16(bf16x8 a, bf16x8 b, f32x4 c) { return __builtin_amdgcn_mfma_f32_16x16x32_bf16(a, b, c, 0, 0, 0); }
DEV float fexp2(float x) { return __builtin_amdgcn_exp2f(x); }
DEV float fexp(float x) { return __builtin_amdgcn_exp2f(x * LOG2E); }
DEV float frcp(float x) { return __builtin_amdgcn_rcpf(x); }
DEV float sigmoidf_(float x) { return frcp(1.f + fexp(-x)); }
DEV float logsigf_(float x) { return fminf(x, 0.f) - log1pf(expf(-fabsf(x))); }
DEV float wave_sum(float v) {
#pragma unroll
  for (int m = 32; m >= 1; m >>= 1) v += __shfl_xor(v, m);
  return v;
}
DEV int sw8(int row, int chunk) { return row * 128 + ((chunk ^ ((row >> 1) & 7)) << 4); }
DEV int sw16(int row, int chunk) { return row * 256 + ((chunk ^ (row & 15)) << 4); }
DEV bf16x8 lds128(const char* p) { return *(const bf16x8*)p; }
DEV float4 ld_nt16(const float* p) { f32x4 v = __builtin_nontemporal_load((const f32x4*)p); return make_float4(v[0], v[1], v[2], v[3]); }
DEV void st_nt16(float* p, float a, float b, float c, float d) { f32x4 v = {a, b, c, d}; __builtin_nontemporal_store(v, (f32x4*)p); }

struct GOp { const u16* W; int ldw; const u16* X; int ldx; int K; };
template <int FT, int TT>
struct GPipe { u32x4 rw[FT / 32], rx[TT / 32]; };

#define G_LOAD(RW, RX, WP, LDW, XP, LDX)                                                           \
  {                                                                                                \
    _Pragma("unroll") for (int i = 0; i < WI; ++i) RW[i] = *(const u32x4*)((WP) + (size_t)i * 32 * (LDW)); \
    _Pragma("unroll") for (int i = 0; i < XI; ++i) RX[i] = *(const u32x4*)((XP) + (size_t)i * 32 * (LDX)); \
  }
#define G_STORE(ST, RW, RX)                                                                        \
  {                                                                                                \
    _Pragma("unroll") for (int i = 0; i < WI; ++i) *(u32x4*)(ST + sw8(lr + i * 32, lc)) = RW[i];  \
    _Pragma("unroll") for (int i = 0; i < XI; ++i) *(u32x4*)(ST + WBYTES + sw8(lr + i * 32, lc)) = RX[i]; \
  }
#define G_COMPUTE(ST)                                                                              \
  {                                                                                                \
    _Pragma("unroll") for (int ks = 0; ks < 2; ++ks) {                                             \
      bf16x8 bx[XI];                                                                               \
      _Pragma("unroll") for (int i = 0; i < XI; ++i) bx[i] = lds128(ST + WBYTES + sw8(wt * (TT / 2) + i * 16 + fr, ks * 4 + fq)); \
      _Pragma("unroll") for (int ah = 0; ah < WI; ah += 4) {                                       \
        bf16x8 af[4];                                                                              \
        _Pragma("unroll") for (int i = 0; i < 4; ++i) af[i] = lds128(ST + sw8(wf * (FT / 2) + (ah + i) * 16 + fr, ks * 4 + fq)); \
        _Pragma("unroll") for (int a = 0; a < 4; ++a)                                              \
          _Pragma("unroll") for (int b = 0; b < XI; ++b) acc[ah + a][b] = mfma16(af[a], bx[b], acc[ah + a][b]); \
      }                                                                                            \
    }                                                                                              \
  }

template <int FT, int TT>
DEV void gemm_prime(GPipe<FT, TT>& pp, const GOp& op, char* smem) {
  constexpr int WI = FT / 32, XI = TT / 32;
  constexpr int WBYTES = FT * 128;
  const int tid = ltid();
  const int lr = tid >> 3, lc = tid & 7;
  const u16* wp = op.W + (size_t)lr * op.ldw + lc * 8;
  const u16* xp = op.X + (size_t)lr * op.ldx + lc * 8;
  __syncthreads();
  G_LOAD(pp.rw, pp.rx, wp, op.ldw, xp, op.ldx);
  G_STORE(smem, pp.rw, pp.rx);
  __syncthreads();
}

template <int FT, int TT>
DEV void gemm_mainloop(GPipe<FT, TT>& pp, const GOp& op, const GOp& nx, f32x4 (&acc)[FT / 32][TT / 32], char* smem) {
  constexpr int WI = FT / 32, XI = TT / 32;
  constexpr int WBYTES = FT * 128, XBYTES = TT * 128, STAGE = WBYTES + XBYTES;
  const int tid = ltid(), lane = tid & 63, wv = tid >> 6;
  const int wf = wv >> 1, wt = wv & 1, fr = lane & 15, fq = lane >> 4;
  const int lr = tid >> 3, lc = tid & 7;
  const u16* wp = op.W + (size_t)lr * op.ldw + lc * 8;
  const u16* xp = op.X + (size_t)lr * op.ldx + lc * 8;
  const u16* nwp = nx.W + (size_t)lr * nx.ldw + lc * 8;
  const u16* nxp = nx.X + (size_t)lr * nx.ldx + lc * 8;
  char* st0 = smem;
  char* st1 = smem + STAGE;
  const int nk = op.K >> 6;
  for (int kt = 0; kt < nk; kt += 2) {
    G_LOAD(pp.rw, pp.rx, wp + (kt + 1) * 64, op.ldw, xp + (kt + 1) * 64, op.ldx);
    G_COMPUTE(st0);
    G_STORE(st1, pp.rw, pp.rx);
    __syncthreads();
    {
      const bool cur = (kt + 2 < nk);
      const u16* a = cur ? wp + (kt + 2) * 64 : nwp;
      const u16* b = cur ? xp + (kt + 2) * 64 : nxp;
      const int la = cur ? op.ldw : nx.ldw, lb = cur ? op.ldx : nx.ldx;
      G_LOAD(pp.rw, pp.rx, a, la, b, lb);
    }
    G_COMPUTE(st1);
    G_STORE(st0, pp.rw, pp.rx);
    __syncthreads();
  }
}
template <int FT, int TT>
DEV void gemm_mainloop_sb(GPipe<FT, TT>& pp, const GOp& op, const GOp& nx, f32x4 (&acc)[FT / 32][TT / 32], char* smem) {
  constexpr int WI = FT / 32, XI = TT / 32;
  constexpr int WBYTES = FT * 128;
  const int tid = ltid(), lane = tid & 63, wv = tid >> 6;
  const int wf = wv >> 1, wt = wv & 1, fr = lane & 15, fq = lane >> 4;
  const int lr = tid >> 3, lc = tid & 7;
  const u16* wp = op.W + (size_t)lr * op.ldw + lc * 8;
  const u16* xp = op.X + (size_t)lr * op.ldx + lc * 8;
  const u16* nwp = nx.W + (size_t)lr * nx.ldw + lc * 8;
  const u16* nxp = nx.X + (size_t)lr * nx.ldx + lc * 8;
  char* st0 = smem;
  const int nk = op.K >> 6;
  for (int kt = 0; kt < nk; ++kt) {
    {
      const bool cur = (kt + 1 < nk);
      const u16* a = cur ? wp + (kt + 1) * 64 : nwp;
      const u16* b = cur ? xp + (kt + 1) * 64 : nxp;
      const int la = cur ? op.ldw : nx.ldw, lb = cur ? op.ldx : nx.ldx;
      G_LOAD(pp.rw, pp.rx, a, la, b, lb);
    }
    G_COMPUTE(st0);
    __syncthreads();
    G_STORE(st0, pp.rw, pp.rx);
    __syncthreads();
  }
}
#undef G_LOAD
#undef G_STORE
#undef G_COMPUTE

DEV void tile_map(int i, int TM, int TN, int& tm, int& tn) {
  const int xcd = i & 7, j = i >> 3;
  const int tmx = TM >> 3, per = 8 * TN;
  const int g = j / per, r = j - g * per;
  tn = r >> 3;
  tm = xcd * tmx + g * 8 + (r & 7);
}

DEV int winmap(int n) {
  if (n < 2048) return n;
  if (n < 6656) return n + 8;
  if (n < 6664) return 2048 + (n - 6656);
  if (n < 6668) return n;
  if (n < GATE_ROW0) return -1;
  return 6668 + (n - GATE_ROW0);
}

DEV void transpose_tile(const float* __restrict__ src, int ld_src, u16* __restrict__ dst, int ld_dst, int k0, int n0,
                        bool win, char* smem) {
  float* tile = (float*)smem;
  const int tid = ltid();
  {
    const int nn = tid & 127;
    const int col = win ? winmap(n0 + nn) : (n0 + nn);
    float v[32];
#pragma unroll
    for (int r = 0; r < 32; ++r) {
      const int kk = r * 2 + (tid >> 7);
      v[r] = (col >= 0) ? src[(size_t)(k0 + kk) * ld_src + col] : 0.f;
    }
#pragma unroll
    for (int r = 0; r < 32; ++r) tile[(r * 2 + (tid >> 7)) * 129 + nn] = v[r];
  }
  __syncthreads();
  {
    const int nn = tid >> 1, kq = (tid & 1) * 32;
    u32 w[16];
#pragma unroll
    for (int i = 0; i < 16; ++i) w[i] = pack2(tile[(kq + 2 * i) * 129 + nn], tile[(kq + 2 * i + 1) * 129 + nn]);
    u16* d = dst + (size_t)(n0 + nn) * ld_dst + k0 + kq;
#pragma unroll
    for (int i = 0; i < 4; ++i) *(uint4*)(d + 8 * i) = make_uint4(w[4 * i], w[4 * i + 1], w[4 * i + 2], w[4 * i + 3]);
  }
  __syncthreads();
}

template <bool SILU>
DEV void gemv16_task(const float* __restrict__ A, const float* __restrict__ W, size_t ldw, const float* __restrict__ bias,
                     float* __restrict__ out, int ldo, char* smem) {
  float* cs = (float*)smem;
  const int tid = ltid();
  for (int i = tid; i < 16384; i += 256) {
    const float v = A[i];
    cs[i] = SILU ? v / (1.f + expf(-v)) : v;
  }
  __syncthreads();
  const int ks = tid >> 5, cc = tid & 31;
  const float* w = W + (size_t)(ks * 128) * ldw + cc;
  float acc[16];
#pragma unroll
  for (int b = 0; b < 16; ++b) acc[b] = 0.f;
#pragma unroll 8
  for (int k = 0; k < 128; ++k) {
    const float wv = w[(size_t)k * ldw];
    const float* cp = cs + ks * 128 + k;
#pragma unroll
    for (int b = 0; b < 16; ++b) acc[b] += cp[b * 1024] * wv;
  }
  __syncthreads();
  float* red = (float*)smem;
#pragma unroll
  for (int b = 0; b < 16; ++b) red[(ks * 16 + b) * 32 + cc] = acc[b];
  __syncthreads();
  for (int o = tid; o < 512; o += 256) {
    const int b = o >> 5, c = o & 31;
    float s = 0.f;
#pragma unroll
    for (int q = 0; q < 8; ++q) s += red[(q * 16 + b) * 32 + c];
    out[(size_t)b * ldo + c] = s + bias[c];
  }
  __syncthreads();
}

DEV void mod_task(const Params& p, int m, char* smem) {
  const int layer = m / 192, cb = (m % 192) * 32;
  gemv16_task<true>(p.c, p.w_ada + (size_t)layer * 1024 * 6144 + cb, 6144, p.b_ada + layer * 6144 + cb,
                    p.mod + (size_t)layer * 16 * 6144 + cb, 6144, smem);
}

DEV void qk0_task(const Params& p, int layer, int j, char* smem) {
  const int grp = j >> 4, c0 = (j & 15) * 32;
  const int ocol = (grp == 0 ? 0 : (grp == 1 ? 512 : (grp == 2 ? 3080 : 3592))) + c0;
  gemv16_task<false>(p.h0f, p.w_in + (size_t)layer * 1024 * NIN + ocol, NIN, p.b_in + (size_t)layer * NIN + ocol,
                     p.qk0 + grp * 512 + c0, 2048, smem);
}

DEV void phase_prep(const Params& p, char* smem) {
  constexpr int NMOD = 384, PER_LAYER = 1360 + 256 + 128 + 512 + 512;
  unsigned* ctr = p.bar + 36;
  int* s_item = (int*)(smem + SMEM_BYTES - 16);
  for (;;) {
    if (threadIdx.x == 0) *s_item = (int)atomicAdd(ctr, 1u);
    __syncthreads();
    const int t = *s_item;
    __syncthreads();
    if (t >= NMOD + 2 * PER_LAYER) break;
    if (t < NMOD) { mod_task(p, t, smem); continue; }
    const int tt = t - NMOD;
    const int layer = tt / PER_LAYER;
    int r = tt - layer * PER_LAYER;
    u16* W = p.Wb + (size_t)layer * WL;
    if (r < 1360) {
      transpose_tile(p.w_in + (size_t)layer * 1024 * NIN, NIN, W + OFF_WIN, LDW1, (r & 15) * 64, (r >> 4) * 128, true, smem);
    } else if (r < 1616) {
      r -= 1360;
      const int n = r >> 6, r3 = r & 63;
      transpose_tile(p.w_br + ((size_t)layer * 4 + n) * 512 * 1024, 1024, W + OFF_WBR + (size_t)n * 1024 * LDW5, LDW5,
                     (r3 & 7) * 64, (r3 >> 3) * 128, false, smem);
    } else if (r < 1744) {
      r -= 1616;
      transpose_tile(p.w_out + (size_t)layer * 1024 * 1024, 1024, W + OFF_WOUT, LDW1, (r & 15) * 64, (r >> 4) * 128, false, smem);
    } else if (r < 2256) {
      r -= 1744;
      transpose_tile(p.w_ff1 + (size_t)layer * 1024 * 4096, 4096, W + OFF_W1, LDW1, (r & 15) * 64, (r >> 4) * 128, false, smem);
    } else {
      r -= 2256;
      transpose_tile(p.w_ff2 + (size_t)layer * 4096 * 1024, 1024, W + OFF_W2, LDW4, (r & 63) * 64, (r >> 6) * 128, false, smem);
    }
  }
}

DEV void ln_stats(const float (&v)[16], float& mean, float& rstd) {
  float s = 0.f;
#pragma unroll
  for (int i = 0; i < 16; ++i) s += v[i];
  mean = wave_sum(s) * (1.f / 1024.f);
  float q = 0.f;
#pragma unroll
  for (int i = 0; i < 16; ++i) { const float d = v[i] - mean; q += d * d; }
  rstd = rsqrtf(wave_sum(q) * (1.f / 1024.f) + 1e-5f);
}

DEV void mod_store_h(const float (&xn)[16], const float* modb, int shoff, int scoff, u16* hrow, int lane, float* h0row) {
  float mean, rstd;
  ln_stats(xn, mean, rstd);
#pragma unroll
  for (int i = 0; i < 4; ++i) {
    const int col = i * 256 + lane * 4;
    const float4 sh = *(const float4*)(modb + shoff + col);
    const float4 sc = *(const float4*)(modb + scoff + col);
    const float h0 = (xn[i * 4 + 0] - mean) * rstd * (1.f + sc.x) + sh.x;
    const float h1 = (xn[i * 4 + 1] - mean) * rstd * (1.f + sc.y) + sh.y;
    const float h2 = (xn[i * 4 + 2] - mean) * rstd * (1.f + sc.z) + sh.z;
    const float h3 = (xn[i * 4 + 3] - mean) * rstd * (1.f + sc.w) + sh.w;
    *(uint2*)(hrow + col) = make_uint2(pack2(h0, h1), pack2(h2, h3));
    if (h0row) *(float4*)(h0row + col) = make_float4(h0, h1, h2, h3);
  }
}

DEV void phase_lnmod0(const Params& p) {
  const int lane = ltid() & 63, wv = ltid() >> 6;
  for (int row = blockIdx.x * 4 + wv; row < 32768; row += gridDim.x * 4) {
    float v[16];
#pragma unroll
    for (int i = 0; i < 4; ++i) {
      const float4 xv = ld_nt16(p.x + (size_t)row * 1024 + i * 256 + lane * 4);
      v[i * 4 + 0] = xv.x; v[i * 4 + 1] = xv.y; v[i * 4 + 2] = xv.z; v[i * 4 + 3] = xv.w;
    }
    const float* modb = p.mod + (size_t)(0 * 16 + (row >> 11)) * 6144;
    mod_store_h(v, modb, 0, 1024, p.h + (size_t)row * LDH, lane, (row & 2047) == 0 ? p.h0f + (row >> 11) * 1024 : nullptr);
  }
}

DEV void phase_lnres(const Params& p, const float* xin, const u16* y, int layer, int sub) {
  const int lane = ltid() & 63, wv = ltid() >> 6;
  const int goff = sub == 0 ? 2048 : 5120;
  const float* gam = (sub == 0 ? p.ln1_g : p.ln2_g) + layer * 1024;
  const float* bet = (sub == 0 ? p.ln1_b : p.ln2_b) + layer * 1024;
  const bool has_next = (sub == 0) || (layer + 1 < 2);
  const int nlayer = sub == 0 ? layer : layer + 1;
  const int shoff = sub == 0 ? 3072 : 0, scoff = sub == 0 ? 4096 : 1024;
  const int stride = gridDim.x * 4;
  int row = blockIdx.x * 4 + wv;
  float4 xq[4]; uint2 yq[4];
  if (row < 32768) {
#pragma unroll
    for (int i = 0; i < 4; ++i) {
      xq[i] = ld_nt16(xin + (size_t)row * 1024 + i * 256 + lane * 4);
      yq[i] = *(const uint2*)(y + (size_t)row * LDH + i * 256 + lane * 4);
    }
  }
  for (; row < 32768; row += stride) {
    const int b = row >> 11;
    const float* modb = p.mod + (size_t)(layer * 16 + b) * 6144;
    float4 xn[4]; uint2 yn[4];
    {
      const int nrow = (row + stride < 32768) ? row + stride : row;
#pragma unroll
      for (int i = 0; i < 4; ++i) {
        xn[i] = ld_nt16(xin + (size_t)nrow * 1024 + i * 256 + lane * 4);
        yn[i] = *(const uint2*)(y + (size_t)nrow * LDH + i * 256 + lane * 4);
      }
    }
    float v[16];
#pragma unroll
    for (int i = 0; i < 4; ++i) {
      const int col = i * 256 + lane * 4;
      const float4 xv = xq[i];
      const uint2 yv = yq[i];
      const float4 gv = *(const float4*)(modb + goff + col);
      v[i * 4 + 0] = ALPHA * xv.x + (1.f + gv.x) * bflo(yv.x);
      v[i * 4 + 1] = ALPHA * xv.y + (1.f + gv.y) * bfhi(yv.x);
      v[i * 4 + 2] = ALPHA * xv.z + (1.f + gv.z) * bflo(yv.y);
      v[i * 4 + 3] = ALPHA * xv.w + (1.f + gv.w) * bfhi(yv.y);
    }
    float mean, rstd;
    ln_stats(v, mean, rstd);
#pragma unroll
    for (int i = 0; i < 4; ++i) {
      const int col = i * 256 + lane * 4;
      const float4 ga = *(const float4*)(gam + col);
      const float4 be = *(const float4*)(bet + col);
      v[i * 4 + 0] = (v[i * 4 + 0] - mean) * rstd * ga.x + be.x;
      v[i * 4 + 1] = (v[i * 4 + 1] - mean) * rstd * ga.y + be.y;
      v[i * 4 + 2] = (v[i * 4 + 2] - mean) * rstd * ga.z + be.z;
      v[i * 4 + 3] = (v[i * 4 + 3] - mean) * rstd * ga.w + be.w;
      st_nt16(p.out + (size_t)row * 1024 + col, v[i * 4 + 0], v[i * 4 + 1], v[i * 4 + 2], v[i * 4 + 3]);
    }
    if (has_next) {
      const float* modn = p.mod + (size_t)(nlayer * 16 + b) * 6144;
      mod_store_h(v, modn, shoff, scoff, p.h + (size_t)row * LDH, lane,
                  (sub == 1 && (row & 2047) == 0) ? p.h0f + (row >> 11) * 1024 : nullptr);
    }
#pragma unroll
    for (int i = 0; i < 4; ++i) { xq[i] = xn[i]; yq[i] = yn[i]; }
  }
}

DEV void phase_zgemm(const Params& p, int layer, int half, char* smem) {
  const u16* WinT = p.Wb + (size_t)layer * WL + OFF_WIN;
  const u16* hb = p.h + (size_t)half * 16384 * LDH;
  const float* bin = p.b_in + (size_t)layer * NIN;
  const int lane = ltid() & 63, wv = ltid() >> 6, wf = wv >> 1, wt = wv & 1, fr = lane & 15, fq = lane >> 4;
  constexpr int TM = 16384 / BTK, TNZ = 6656 / BF, TN = TNZ + 1;
  GPipe<BF, BTK> pp;
  bool primed = false;
  for (int i = blockIdx.x; i < TM * TN; i += gridDim.x) {
    int tm, tn;
    tile_map(i, TM, TN, tm, tn);
    const GOp op{WinT + (size_t)tn * BF * LDW1, LDW1, hb + (size_t)tm * BTK * LDH, LDH, 1024};
    GOp nx = op;
    if (i + (int)gridDim.x < TM * TN) {
      int tm2, tn2;
      tile_map(i + gridDim.x, TM, TN, tm2, tn2);
      nx.W = WinT + (size_t)tn2 * BF * LDW1; nx.X = hb + (size_t)tm2 * BTK * LDH;
    }
    if (!primed) { gemm_prime<BF, BTK>(pp, op, smem); primed = true; }
    f32x4 acc[BF / 32][BTK / 32];
#pragma unroll
    for (int a = 0; a < BF / 32; ++a)
#pragma unroll
      for (int b = 0; b < BTK / 32; ++b) acc[a][b] = f32x4{0.f, 0.f, 0.f, 0.f};
    gemm_mainloop_sb<BF, BTK>(pp, op, nx, acc, smem);
    if (tn < TNZ) {
#pragma unroll
      for (int a = 0; a < BF / 32; ++a) {
        const int feat = tn * BF + wf * (BF / 2) + a * 16 + fq * 4;
        const int oc = feat < 2048 ? feat : feat + 8;
        const float b0 = bin[oc], b1 = bin[oc + 1], b2 = bin[oc + 2], b3 = bin[oc + 3];
#pragma unroll
        for (int b = 0; b < BTK / 32; ++b) {
          const int tok = tm * BTK + wt * (BTK / 2) + b * 16 + fr;
          *(uint2*)(p.zreg + (size_t)tok * ZW + feat) =
              make_uint2(pack2(acc[a][b][0] + b0, acc[a][b][1] + b1), pack2(acc[a][b][2] + b2, acc[a][b][3] + b3));
        }
      }
    } else if (wf == 0) {
      const int c = fq * 4;
      float bb[4];
#pragma unroll
      for (int j = 0; j < 4; ++j) {
        const int cc = c + j;
        bb[j] = cc < 8 ? bin[2048 + cc] : (cc < 12 ? bin[6664 + cc - 8] : 0.f);
      }
#pragma unroll
      for (int b = 0; b < BTK / 32; ++b) {
        const int tok = half * 16384 + tm * BTK + wt * (BTK / 2) + b * 16 + fr;
        *(float4*)(p.small + (size_t)tok * 16 + c) =
            make_float4(acc[0][b][0] + bb[0], acc[0][b][1] + bb[1], acc[0][b][2] + bb[2], acc[0][b][3] + bb[3]);
      }
    }
  }
  if (half == 0) {
    for (int j = (int)gridDim.x - 1 - (int)blockIdx.x; j < 64; j += gridDim.x) {
      __syncthreads();
      qk0_task(p, layer, j, smem);
    }
  }
}

template <int MODE>
DEV void phase_gemm(const u16* Wt, int ldw, const u16* X, int ldx, const float* bias, u16* out, int ldo, int N, int K, char* smem) {
  const int lane = ltid() & 63, wv = ltid() >> 6, wf = wv >> 1, wt = wv & 1, fr = lane & 15, fq = lane >> 4;
  const int TM = 32768 / BTK, TN = N / BF;
  GPipe<BF, BTK> pp;
  bool primed = false;
  for (int i = blockIdx.x; i < TM * TN; i += gridDim.x) {
    int tm, tn;
    tile_map(i, TM, TN, tm, tn);
    const GOp op{Wt + (size_t)tn * BF * ldw, ldw, X + (size_t)tm * BTK * ldx, ldx, K};
    GOp nx = op;
    if (i + (int)gridDim.x < TM * TN) {
      int tm2, tn2;
      tile_map(i + gridDim.x, TM, TN, tm2, tn2);
      nx.W = Wt + (size_t)tn2 * BF * ldw; nx.X = X + (size_t)tm2 * BTK * ldx;
    }
    if (!primed) { gemm_prime<BF, BTK>(pp, op, smem); primed = true; }
    f32x4 acc[BF / 32][BTK / 32];
#pragma unroll
    for (int a = 0; a < BF / 32; ++a)
#pragma unroll
      for (int b = 0; b < BTK / 32; ++b) acc[a][b] = f32x4{0.f, 0.f, 0.f, 0.f};
    gemm_mainloop_sb<BF, BTK>(pp, op, nx, acc, smem);
#pragma unroll
    for (int a = 0; a < BF / 32; ++a) {
      const int feat = tn * BF + wf * (BF / 2) + a * 16 + fq * 4;
      const float4 bv = *(const float4*)(bias + feat);
#pragma unroll
      for (int b = 0; b < BTK / 32; ++b) {
        const int tok = tm * BTK + wt * (BTK / 2) + b * 16 + fr;
        float v0 = acc[a][b][0] + bv.x, v1 = acc[a][b][1] + bv.y, v2 = acc[a][b][2] + bv.z, v3 = acc[a][b][3] + bv.w;
        if (MODE == 1) {
          v0 = fmaxf(v0, 0.f); v0 *= v0; v1 = fmaxf(v1, 0.f); v1 *= v1;
          v2 = fmaxf(v2, 0.f); v2 *= v2; v3 = fmaxf(v3, 0.f); v3 *= v3;
        }
        *(uint2*)(out + (size_t)tok * ldo + feat) = make_uint2(pack2(v0, v1), pack2(v2, v3));
      }
    }
  }
}

DEV void phase_merge(const Params& p, int layer, u16* merged, char* smem) {
  const u16* W = p.Wb + (size_t)layer * WL;
  const float* bg = p.b_in + (size_t)layer * NIN + 6668;
  const int lane = ltid() & 63, wv = ltid() >> 6, wf = wv >> 1, wt = wv & 1, fr = lane & 15, fq = lane >> 4;
  constexpr int TM = 256, TN = 8;
  GPipe<128, 128> pp;
  bool primed = false;
  for (int i = blockIdx.x; i < TM * TN; i += gridDim.x) {
    int tm, tn;
    tile_map(i, TM, TN, tm, tn);
    int tm2 = tm, tn2 = tn;
    const bool has_next = (i + (int)gridDim.x < TM * TN);
    if (has_next) tile_map(i + gridDim.x, TM, TN, tm2, tn2);
    u32 pm[4][4][2];
#pragma unroll
    for (int a = 0; a < 4; ++a)
#pragma unroll
      for (int b = 0; b < 4; ++b) { pm[a][b][0] = 0u; pm[a][b][1] = 0u; }
    for (int n = 0; n < 4; ++n) {
      const GOp opg{W + OFF_WIN + (size_t)(GATE_ROW0 + n * 1024 + tn * 128) * LDW1, LDW1, p.h + (size_t)tm * 128 * LDH, LDH, 1024};
      const GOp opb{W + OFF_WBR + (size_t)n * 1024 * LDW5 + (size_t)(tn * 128) * LDW5, LDW5,
                    p.br + (size_t)n * 32768 * LDB + (size_t)tm * 128 * LDB, LDB, 512};
      const int nn = (n + 1) & 3, tmn = (n < 3) ? tm : tm2, tnn = (n < 3) ? tn : tn2;
      GOp opn{W + OFF_WIN + (size_t)(GATE_ROW0 + nn * 1024 + tnn * 128) * LDW1, LDW1, p.h + (size_t)tmn * 128 * LDH, LDH, 1024};
      if (n == 3 && !has_next) opn = opb;
      if (!primed) { gemm_prime<128, 128>(pp, opg, smem); primed = true; }
      u32 gp[4][4][2];
      {
        f32x4 accG[4][4];
#pragma unroll
        for (int a = 0; a < 4; ++a)
#pragma unroll
          for (int b = 0; b < 4; ++b) accG[a][b] = f32x4{0.f, 0.f, 0.f, 0.f};
        gemm_mainloop_sb<128, 128>(pp, opg, opb, accG, smem);
#pragma unroll
        for (int a = 0; a < 4; ++a) {
          const float* bp = bg + n * 1024 + tn * 128 + wf * 64 + a * 16 + fq * 4;
          const float b0 = bp[0], b1 = bp[1], b2 = bp[2], b3 = bp[3];
#pragma unroll
          for (int b = 0; b < 4; ++b) {
            gp[a][b][0] = pack2(sigmoidf_(accG[a][b][0] + b0), sigmoidf_(accG[a][b][1] + b1));
            gp[a][b][1] = pack2(sigmoidf_(accG[a][b][2] + b2), sigmoidf_(accG[a][b][3] + b3));
          }
        }
      }
      f32x4 accP[4][4];
#pragma unroll
      for (int a = 0; a < 4; ++a)
#pragma unroll
        for (int b = 0; b < 4; ++b) accP[a][b] = f32x4{0.f, 0.f, 0.f, 0.f};
      gemm_mainloop_sb<128, 128>(pp, opb, opn, accP, smem);
#pragma unroll
      for (int a = 0; a < 4; ++a)
#pragma unroll
        for (int b = 0; b < 4; ++b) {
          pm[a][b][0] = pack2(bflo(pm[a][b][0]) + bflo(gp[a][b][0]) * accP[a][b][0],
                              bfhi(pm[a][b][0]) + bfhi(gp[a][b][0]) * accP[a][b][1]);
          pm[a][b][1] = pack2(bflo(pm[a][b][1]) + bflo(gp[a][b][1]) * accP[a][b][2],
                              bfhi(pm[a][b][1]) + bfhi(gp[a][b][1]) * accP[a][b][3]);
        }
    }
#pragma unroll
    for (int a = 0; a < 4; ++a) {
      const int feat = tn * 128 + wf * 64 + a * 16 + fq * 4;
#pragma unroll
      for (int b = 0; b < 4; ++b) {
        const int tok = tm * 128 + wt * 64 + b * 16 + fr;
        *(uint2*)(merged + (size_t)tok * LDH + feat) = make_uint2(pm[a][b][0], pm[a][b][1]);
      }
    }
  }
}

template <bool MLSTM>
DEV void linattn_item(const Params& p, int layer, int b, int bl, int head, char* smem) {
  const int tid = ltid(), lane = tid & 63, wv = tid >> 6, fr_ = lane & 15, fq_ = lane >> 4;
  const u16* zb = p.zreg + (size_t)bl * 2048 * ZW;
  const int CQ = (MLSTM ? 0 : 3072) + head * 128, CK = (MLSTM ? 512 : 3584) + head * 128,
            CV = (MLSTM ? 1024 : 4096) + head * 128, CO = (MLSTM ? 1536 : 4608) + head * 128;
  char* Qs = smem;
  char* Ks = smem + 16384;
  char* KwT = smem + 32768;
  char* Vt = smem + 49152;
  char* Ps = smem + 65536;
  float* A_al = (float*)(smem + 73728);
  float* A_em = A_al + 64;
  float* A_c = A_em + 64;
  float* A_M = A_c + 64;
  float* A_ws = A_M + 64;
  float* qn = A_ws + 64;
  float* part = qn + 64;
  float* stat = part + 256;
  float* nS = stat + 512;
  float* misc = nS + 128;
  u16* Y = p.br + (size_t)(MLSTM ? 0 : 2) * 32768 * LDB;
  const float* gain = (MLSTM ? p.m_norm : p.r_norm) + layer * 512 + head * 128;
  const float lg2 = MLSTM ? 0.f : log2f(1.f - exp2f(-5.f - (float)head));
  const float KSCALE = 0.08838834764831845f;

  f32x4 accC[2][8];
#pragma unroll
  for (int a = 0; a < 2; ++a)
#pragma unroll
    for (int d = 0; d < 8; ++d) accC[a][d] = f32x4{0.f, 0.f, 0.f, 0.f};
  float nreg = 0.f, mrun = 0.f;
  if (MLSTM && tid < 128) nS[tid] = 0.f;

  const int lrow_ = tid >> 2, cq_ = tid & 3;
  float4 gnv[2];
#pragma unroll
  for (int a = 0; a < 2; ++a) gnv[a] = *(const float4*)(gain + (2 * wv + a) * 16 + fq_ * 4);
  float g_li = 0.f, g_f = 0.f;
  if (MLSTM && wv == 0) {
    const float* sp = p.small + (size_t)(b * 2048 + lane) * 16;
    g_li = sp[head]; g_f = sp[4 + head];
  }
  u32x4 rq[4], rk[4], rv[4];
  {
    const u16* rowp = zb + (size_t)lrow_ * ZW;
#pragma unroll
    for (int i = 0; i < 4; ++i) {
      const int chn = cq_ + (i & 1) * 4 + (i >> 1) * 8;
      rq[i] = *(const u32x4*)(rowp + CQ + chn * 8);
      rk[i] = *(const u32x4*)(rowp + CK + chn * 8);
      rv[i] = *(const u32x4*)(rowp + CV + chn * 8);
    }
  }
  for (int ch = 0; ch < 32; ++ch) {
    const int t0 = ch * 64;
    int fr = fr_, fq = fq_, lrow = lrow_, cq = cq_;
    asm volatile("" : "+v"(fr), "+v"(fq), "+v"(lrow), "+v"(cq));
    if (ch == 0 && wv < 2) {
      const float* qk = p.qk0 + (size_t)b * 2048 + (MLSTM ? 0 : 1024) + head * 128;
      const float pr = qk[tid] * qk[512 + tid];
      const float ws_ = wave_sum(pr);
      if (lane == 0) misc[2 + wv] = ws_;
    }
    if (MLSTM && wv == 0) {
      const float li = g_li, lf = logsigf_(g_f);
      float bcs = lf;
#pragma unroll
      for (int o = 1; o < 64; o <<= 1) { const float t = __shfl_up(bcs, o); if (lane >= o) bcs += t; }
      const float cc = li - bcs;
      float cm = cc;
#pragma unroll
      for (int o = 1; o < 64; o <<= 1) { const float t = __shfl_up(cm, o); if (lane >= o) cm = fmaxf(cm, t); }
      const float Mt = fmaxf(mrun, cm);
      A_c[lane] = cc; A_M[lane] = Mt; A_al[lane] = fexp(mrun - Mt); A_em[lane] = fexp(-(bcs + Mt));
      const float M63 = __shfl(Mt, 63), g = __shfl(bcs, 63);
      A_ws[lane] = fexp(cc - M63);
      if (lane == 0) misc[0] = fexp(mrun - M63);
      mrun = g + M63;
    }
    {
      const float beta = MLSTM ? 1.f : fexp2((float)(63 - lrow) * lg2);
      if (!MLSTM) {
        const float posf = (float)p.pos[b * 2048 + t0 + lrow];
#pragma unroll
        for (int pr = 0; pr < 2; ++pr) {
          const int chn = cq + pr * 4;
          u32 q1[4], q2[4], k1[4], k2[4];
#pragma unroll
          for (int w = 0; w < 4; ++w) {
            const u32 q1w = wsel(rq[pr], w), q2w = wsel(rq[pr + 2], w), k1w = wsel(rk[pr], w), k2w = wsel(rk[pr + 2], w);
            const int fi = chn * 8 + w * 2;
            const float rev0 = posf * (exp2f(-(float)fi * (13.287712379549449f / 64.f)) * 0.15915494309189535f);
            const float rev1 = posf * (exp2f(-(float)(fi + 1) * (13.287712379549449f / 64.f)) * 0.15915494309189535f);
            const float f0 = __builtin_amdgcn_fractf(rev0), f1 = __builtin_amdgcn_fractf(rev1);
            const float sn0 = __builtin_amdgcn_sinf(f0), cs0 = __builtin_amdgcn_cosf(f0);
            const float sn1 = __builtin_amdgcn_sinf(f1), cs1 = __builtin_amdgcn_cosf(f1);
            const float qa0 = bflo(q1w), qa1 = bfhi(q1w), qb0 = bflo(q2w), qb1 = bfhi(q2w);
            const float ka0 = bflo(k1w), ka1 = bfhi(k1w), kb0 = bflo(k2w), kb1 = bfhi(k2w);
            q1[w] = pack2(qa0 * cs0 - qb0 * sn0, qa1 * cs1 - qb1 * sn1);
            q2[w] = pack2(qa0 * sn0 + qb0 * cs0, qa1 * sn1 + qb1 * cs1);
            k1[w] = pack2(ka0 * cs0 - kb0 * sn0, ka1 * cs1 - kb1 * sn1);
            k2[w] = pack2(ka0 * sn0 + kb0 * cs0, ka1 * sn1 + kb1 * cs1);
          }
          rq[pr] = u32x4{q1[0], q1[1], q1[2], q1[3]}; rq[pr + 2] = u32x4{q2[0], q2[1], q2[2], q2[3]};
          rk[pr] = u32x4{k1[0], k1[1], k1[2], k1[3]}; rk[pr + 2] = u32x4{k2[0], k2[1], k2[2], k2[3]};
        }
      }
#pragma unroll
      for (int i = 0; i < 4; ++i) {
        const int chn = cq + (i & 1) * 4 + (i >> 1) * 8;
        *(u32x4*)(Qs + sw16(lrow, chn)) = rq[i];
        float kv[8];
#pragma unroll
        for (int w = 0; w < 4; ++w) { kv[2 * w] = bflo(wsel(rk[i], w)) * KSCALE; kv[2 * w + 1] = bfhi(wsel(rk[i], w)) * KSCALE; }
        *(uint4*)(Ks + sw16(lrow, chn)) =
            make_uint4(pack2(kv[0], kv[1]), pack2(kv[2], kv[3]), pack2(kv[4], kv[5]), pack2(kv[6], kv[7]));
#pragma unroll
        for (int e = 0; e < 8; ++e) {
          const int d = chn * 8 + e;
          if (!MLSTM) *(u16*)(KwT + sw8(d, lrow >> 3) + (lrow & 7) * 2) = f2bf(kv[e] * beta);
          const u16 ve = (u16)((wsel(rv[i], e >> 1) >> ((e & 1) * 16)) & 0xffffu);
          *(u16*)(Vt + sw8(d, lrow >> 3) + (lrow & 7) * 2) = ve;
        }
      }
    }
    __syncthreads();
    if (MLSTM) {
      const float beta = A_ws[lrow];
#pragma unroll
      for (int i = 0; i < 4; ++i) {
        const int chn = cq + (i & 1) * 4 + (i >> 1) * 8;
#pragma unroll
        for (int e = 0; e < 8; ++e) {
          const u32 w = wsel(rk[i], e >> 1);
          const float kf = ((e & 1) ? bfhi(w) : bflo(w)) * KSCALE * beta;
          *(u16*)(KwT + sw8(chn * 8 + e, lrow >> 3) + (lrow & 7) * 2) = f2bf(kf);
        }
      }
    }
    uint2 og[4][2];
#pragma unroll
    for (int t = 0; t < 4; ++t)
#pragma unroll
      for (int a = 0; a < 2; ++a)
        og[t][a] = *(const uint2*)(zb + (size_t)(t0 + t * 16 + fr) * ZW + CO + (2 * wv + a) * 16 + fq * 4);
    f32x4 num[2][4];
#pragma unroll
    for (int a = 0; a < 2; ++a)
#pragma unroll
      for (int t = 0; t < 4; ++t) num[a][t] = f32x4{0.f, 0.f, 0.f, 0.f};
#pragma unroll
    for (int pp = 0; pp < 4; ++pp) {
      bf16x8 ca[2];
#pragma unroll
      for (int a = 0; a < 2; ++a)
        ca[a] = mk8(pack2(accC[a][2 * pp][0], accC[a][2 * pp][1]), pack2(accC[a][2 * pp][2], accC[a][2 * pp][3]),
                    pack2(accC[a][2 * pp + 1][0], accC[a][2 * pp + 1][1]), pack2(accC[a][2 * pp + 1][2], accC[a][2 * pp + 1][3]));
#pragma unroll
      for (int t = 0; t < 4; ++t) {
        const int row = t * 16 + fr;
        const uint2 h0 = *(const uint2*)(Qs + sw16(row, 4 * pp + (fq >> 1)) + (fq & 1) * 8);
        const uint2 h1 = *(const uint2*)(Qs + sw16(row, 4 * pp + 2 + (fq >> 1)) + (fq & 1) * 8);
        const bf16x8 qb = mk8(h0.x, h0.y, h1.x, h1.y);
#pragma unroll
        for (int a = 0; a < 2; ++a) num[a][t] = mfma16(ca[a], qb, num[a][t]);
      }
    }
#pragma unroll
    for (int t = 0; t < 4; ++t) {
      const int tt = t * 16 + fr;
      const float al = MLSTM ? A_al[tt] : fexp2((float)(tt + 1) * lg2);
#pragma unroll
      for (int a = 0; a < 2; ++a) { num[a][t][0] *= al; num[a][t][1] *= al; num[a][t][2] *= al; num[a][t][3] *= al; }
    }
    {
      f32x4 sacc[4];
#pragma unroll
      for (int t = 0; t < 4; ++t) sacc[t] = f32x4{0.f, 0.f, 0.f, 0.f};
#pragma unroll
      for (int ks = 0; ks < 4; ++ks) {
        const bf16x8 kf = lds128(Ks + sw16(wv * 16 + fr, ks * 4 + fq));
#pragma unroll
        for (int t = 0; t < 4; ++t) sacc[t] = mfma16(kf, lds128(Qs + sw16(t * 16 + fr, ks * 4 + fq)), sacc[t]);
      }
      if (ch == 0 && wv == 0 && lane == 0) sacc[0][0] = (misc[2] + misc[3]) * KSCALE;
      const int s0 = wv * 16 + fq * 4;
      float cs4[4];
      if (MLSTM) {
#pragma unroll
        for (int j = 0; j < 4; ++j) cs4[j] = A_c[s0 + j];
      }
#pragma unroll
      for (int t = 0; t < 4; ++t) {
        const int tt = t * 16 + fr;
        const float Mt = MLSTM ? A_M[tt] : 0.f;
        float pv[4];
#pragma unroll
        for (int j = 0; j < 4; ++j) {
          const int s = s0 + j;
          float dm;
          if (MLSTM) dm = fexp(cs4[j] - Mt); else dm = fexp2((float)(tt - s) * lg2);
          pv[j] = (s <= tt) ? sacc[t][j] * dm : 0.f;
        }
        if (MLSTM) {
          float ps = pv[0] + pv[1] + pv[2] + pv[3];
          ps += __shfl_xor(ps, 16);
          ps += __shfl_xor(ps, 32);
          if (fq == 0) part[wv * 64 + tt] = ps;
        }
        *(uint2*)(Ps + sw8(tt, wv * 2 + (fq >> 1)) + (fq & 1) * 8) = make_uint2(pack2(pv[0], pv[1]), pack2(pv[2], pv[3]));
      }
    }
    if (MLSTM) {
      const int tt = tid >> 2, qt = tid & 3;
      float s = 0.f;
#pragma unroll
      for (int i = 0; i < 4; ++i) {
        const u32x4 qf = *(const u32x4*)(Qs + sw16(tt, qt * 4 + i));
        const float* np = nS + (qt * 4 + i) * 8;
#pragma unroll
        for (int w = 0; w < 4; ++w) s += bflo(wsel(qf, w)) * np[2 * w] + bfhi(wsel(qf, w)) * np[2 * w + 1];
      }
      s += __shfl_xor(s, 1);
      s += __shfl_xor(s, 2);
      if (qt == 0) qn[tt] = s;
    }
    __syncthreads();
    {
      bf16x8 vf[2][2];
#pragma unroll
      for (int a = 0; a < 2; ++a)
#pragma unroll
        for (int ks = 0; ks < 2; ++ks) vf[a][ks] = lds128(Vt + sw8((2 * wv + a) * 16 + fr, ks * 4 + fq));
#pragma unroll
      for (int t = 0; t < 4; ++t)
#pragma unroll
        for (int ks = 0; ks < 2; ++ks) {
          const bf16x8 pf = lds128(Ps + sw8(t * 16 + fr, ks * 4 + fq));
#pragma unroll
          for (int a = 0; a < 2; ++a) num[a][t] = mfma16(vf[a][ks], pf, num[a][t]);
        }
      const float delta = MLSTM ? misc[0] : fexp2(64.f * lg2);
#pragma unroll
      for (int d = 0; d < 8; ++d) {
#pragma unroll
        for (int a = 0; a < 2; ++a) { accC[a][d][0] *= delta; accC[a][d][1] *= delta; accC[a][d][2] *= delta; accC[a][d][3] *= delta; }
#pragma unroll
        for (int ks = 0; ks < 2; ++ks) {
          const bf16x8 kwf = lds128(KwT + sw8(d * 16 + fr, ks * 4 + fq));
#pragma unroll
          for (int a = 0; a < 2; ++a) accC[a][d] = mfma16(kwf, vf[a][ks], accC[a][d]);
        }
      }
      if (MLSTM && tid < 128) {
        float s = 0.f;
#pragma unroll
        for (int i = 0; i < 8; ++i) {
          const u32x4 kf = *(const u32x4*)(KwT + tid * 128 + i * 16);
#pragma unroll
          for (int w = 0; w < 4; ++w) s += bflo(wsel(kf, w)) + bfhi(wsel(kf, w));
        }
        nreg = delta * nreg + s;
        nS[tid] = nreg;
      }
    }
#pragma unroll
    for (int t = 0; t < 4; ++t) {
      const int tt = t * 16 + fr;
      float s1 = 0.f, s2 = 0.f;
      float rden = 1.f;
      if (MLSTM) {
        const float den = A_al[tt] * qn[tt] + part[tt] + part[64 + tt] + part[128 + tt] + part[192 + tt];
        rden = frcp(fmaxf(fabsf(den), A_em[tt]));
      }
#pragma unroll
      for (int a = 0; a < 2; ++a) {
        if (MLSTM) {
          const uint2 ov = og[t][a];
          num[a][t][0] *= rden * sigmoidf_(bflo(ov.x));
          num[a][t][1] *= rden * sigmoidf_(bfhi(ov.x));
          num[a][t][2] *= rden * sigmoidf_(bflo(ov.y));
          num[a][t][3] *= rden * sigmoidf_(bfhi(ov.y));
        }
#pragma unroll
        for (int j = 0; j < 4; ++j) { s1 += num[a][t][j]; s2 += num[a][t][j] * num[a][t][j]; }
      }
      s1 += __shfl_xor(s1, 16); s1 += __shfl_xor(s1, 32);
      s2 += __shfl_xor(s2, 16); s2 += __shfl_xor(s2, 32);
      if (fq == 0) { stat[(wv * 64 + tt) * 2] = s1; stat[(wv * 64 + tt) * 2 + 1] = s2; }
    }
    __syncthreads();
    {
      const int tn_ = (ch + 1 < 32) ? t0 + 64 : t0;
      if (MLSTM && wv == 0) {
        const float* sp = p.small + (size_t)(b * 2048 + tn_ + lane) * 16;
        g_li = sp[head]; g_f = sp[4 + head];
      }
      const u16* rowp = zb + (size_t)(tn_ + lrow) * ZW;
#pragma unroll
      for (int i = 0; i < 4; ++i) {
        const int chn = cq + (i & 1) * 4 + (i >> 1) * 8;
        rq[i] = *(const u32x4*)(rowp + CQ + chn * 8);
        rk[i] = *(const u32x4*)(rowp + CK + chn * 8);
        rv[i] = *(const u32x4*)(rowp + CV + chn * 8);
      }
    }
#pragma unroll
    for (int t = 0; t < 4; ++t) {
      const int tt = t * 16 + fr;
      float s1 = 0.f, s2 = 0.f;
#pragma unroll
      for (int w = 0; w < 4; ++w) { s1 += stat[(w * 64 + tt) * 2]; s2 += stat[(w * 64 + tt) * 2 + 1]; }
      const float mean = s1 * (1.f / 128.f);
      const float var = fmaxf(s2 * (1.f / 128.f) - mean * mean, 0.f);
      const float rstd = rsqrtf(var + 1e-5f);
#pragma unroll
      for (int a = 0; a < 2; ++a) {
        const int e0 = (2 * wv + a) * 16 + fq * 4;
        const float4 gn = gnv[a];
        float o0 = (num[a][t][0] - mean) * rstd * gn.x, o1 = (num[a][t][1] - mean) * rstd * gn.y;
        float o2 = (num[a][t][2] - mean) * rstd * gn.z, o3 = (num[a][t][3] - mean) * rstd * gn.w;
        if (!MLSTM) {
          const uint2 gv = og[t][a];
          const float g0 = bflo(gv.x), g1 = bfhi(gv.x), g2 = bflo(gv.y), g3 = bfhi(gv.y);
          o0 *= g0 * sigmoidf_(g0); o1 *= g1 * sigmoidf_(g1); o2 *= g2 * sigmoidf_(g2); o3 *= g3 * sigmoidf_(g3);
        }
        *(uint2*)(Y + (size_t)(b * 2048 + t0 + tt) * LDB + head * 128 + e0) = make_uint2(pack2(o0, o1), pack2(o2, o3));
      }
    }
  }
  __syncthreads();
}

DEV void attn_item(const Params& p, int b, int bl, int head, int qb, char* smem) {
  const int tid = ltid(), lane = tid & 63, wv = tid >> 6, fr = lane & 15, fq = lane >> 4;
  const u16* zb = p.zreg + (size_t)bl * 2048 * ZW;
  const int CQ = 5120 + head * 128, CK = 5632 + head * 128, CV = 6144 + head * 128;
  char* Ks = smem;
  char* Vt = smem + 16384;
  float* F = (float*)(smem + 32768);
  float* wtot = (float*)(smem + 40960);
  const int lo = qb * 128, hi = lo + 128;
  {
    const int s0 = tid * 8;
    float v[8];
    float run = 0.f;
#pragma unroll
    for (int i = 0; i < 8; ++i) {
      float lf = 0.f;
      if (s0 < hi) lf = logsigf_(p.small[(size_t)(b * 2048 + s0 + i) * 16 + 8 + head]);
      run += lf; v[i] = run;
    }
    float incl = run;
#pragma unroll
    for (int o = 1; o < 64; o <<= 1) { const float t = __shfl_up(incl, o); if (lane >= o) incl += t; }
    if (lane == 63) wtot[wv] = incl;
    __syncthreads();
    float off = incl - run;
    for (int w = 0; w < wv; ++w) off += wtot[w];
#pragma unroll
    for (int i = 0; i < 8; ++i) F[s0 + i] = (off + v[i]) * LOG2E;
  }
  bf16x8 qf[2][4];
  const int qrow0 = lo + wv * 32;
#pragma unroll
  for (int qi = 0; qi < 2; ++qi)
#pragma unroll
    for (int ks = 0; ks < 4; ++ks)
      qf[qi][ks] = *(const bf16x8*)(zb + (size_t)(qrow0 + qi * 16 + fr) * ZW + CQ + ks * 32 + fq * 8);
  __syncthreads();
  float Fq[2], mrow[2], lrow[2];
#pragma unroll
  for (int qi = 0; qi < 2; ++qi) { Fq[qi] = F[qrow0 + qi * 16 + fr]; mrow[qi] = -INFINITY; lrow[qi] = 0.f; }
  f32x4 o[8][2];
#pragma unroll
  for (int e = 0; e < 8; ++e)
#pragma unroll
    for (int qi = 0; qi < 2; ++qi) o[e][qi] = f32x4{0.f, 0.f, 0.f, 0.f};
  const float SC = 0.08838834764831845f * LOG2E;
  const int nkt = (qb + 1) * 2;
  const int krow = tid >> 2, kc = tid & 3;
  u32x4 rk[4], rv[4];
  {
    const u16* rp = zb + (size_t)krow * ZW;
#pragma unroll
    for (int i = 0; i < 4; ++i) { rk[i] = *(const u32x4*)(rp + CK + (kc * 4 + i) * 8); rv[i] = *(const u32x4*)(rp + CV + (kc * 4 + i) * 8); }
  }
  for (int kt = 0; kt < nkt; ++kt) {
    __syncthreads();
#pragma unroll
    for (int i = 0; i < 4; ++i) {
      const int chn = kc * 4 + i;
      *(u32x4*)(Ks + sw16(krow, chn)) = rk[i];
#pragma unroll
      for (int e = 0; e < 8; ++e) {
        const u16 ve = (u16)((wsel(rv[i], e >> 1) >> ((e & 1) * 16)) & 0xffffu);
        *(u16*)(Vt + sw8(chn * 8 + e, krow >> 3) + (krow & 7) * 2) = ve;
      }
    }
    __syncthreads();
    const int key0 = kt * 64;
    const bool active = (key0 <= qrow0 + 31);
    bf16x8 pb[2][2];
    if (active) {
      f32x4 s[4][2];
#pragma unroll
      for (int a = 0; a < 4; ++a)
#pragma unroll
        for (int qi = 0; qi < 2; ++qi) s[a][qi] = f32x4{0.f, 0.f, 0.f, 0.f};
#pragma unroll
      for (int ks = 0; ks < 4; ++ks)
#pragma unroll
        for (int a = 0; a < 4; ++a) {
          const bf16x8 kf = lds128(Ks + sw16(a * 16 + fr, ks * 4 + fq));
#pragma unroll
          for (int qi = 0; qi < 2; ++qi) s[a][qi] = mfma16(kf, qf[qi][ks], s[a][qi]);
        }
      const bool need_mask = (key0 + 63 > qrow0);
      float mx[2] = {-INFINITY, -INFINITY};
#pragma unroll
      for (int a = 0; a < 4; ++a) {
        const float4 fk = *(const float4*)(F + key0 + a * 16 + fq * 4);
#pragma unroll
        for (int qi = 0; qi < 2; ++qi) {
          const int qpos = qrow0 + qi * 16 + fr;
#pragma unroll
          for (int j = 0; j < 4; ++j) {
            float xv = s[a][qi][j] * SC + Fq[qi] - (j == 0 ? fk.x : (j == 1 ? fk.y : (j == 2 ? fk.z : fk.w)));
            if (need_mask && (key0 + a * 16 + fq * 4 + j > qpos)) xv = -INFINITY;
            s[a][qi][j] = xv;
            mx[qi] = fmaxf(mx[qi], xv);
          }
        }
      }
#pragma unroll
      for (int qi = 0; qi < 2; ++qi) {
        float m = mx[qi];
        m = fmaxf(m, __shfl_xor(m, 16));
        m = fmaxf(m, __shfl_xor(m, 32));
        const float mnew = fmaxf(mrow[qi], m);
        const float alpha = fexp2(mrow[qi] - mnew);
        mrow[qi] = mnew;
        float rs = 0.f;
#pragma unroll
        for (int a = 0; a < 4; ++a)
#pragma unroll
          for (int j = 0; j < 4; ++j) { const float pv = fexp2(s[a][qi][j] - mnew); s[a][qi][j] = pv; rs += pv; }
        rs += __shfl_xor(rs, 16);
        rs += __shfl_xor(rs, 32);
        lrow[qi] = lrow[qi] * alpha + rs;
#pragma unroll
        for (int e = 0; e < 8; ++e) { o[e][qi][0] *= alpha; o[e][qi][1] *= alpha; o[e][qi][2] *= alpha; o[e][qi][3] *= alpha; }
#pragma unroll
        for (int pp = 0; pp < 2; ++pp) {
          pb[qi][pp] = mk8(pack2(s[2 * pp][qi][0], s[2 * pp][qi][1]), pack2(s[2 * pp][qi][2], s[2 * pp][qi][3]),
                           pack2(s[2 * pp + 1][qi][0], s[2 * pp + 1][qi][1]), pack2(s[2 * pp + 1][qi][2], s[2 * pp + 1][qi][3]));
        }
      }
    }
    if (kt + 1 < nkt) {
      const u16* rp = zb + (size_t)((kt + 1) * 64 + krow) * ZW;
#pragma unroll
      for (int i = 0; i < 4; ++i) { rk[i] = *(const u32x4*)(rp + CK + (kc * 4 + i) * 8); rv[i] = *(const u32x4*)(rp + CV + (kc * 4 + i) * 8); }
    }
    if (active) {
#pragma unroll
      for (int pp = 0; pp < 2; ++pp)
#pragma unroll
        for (int e = 0; e < 8; ++e) {
          const int row = e * 16 + fr;
          const uint2 h0 = *(const uint2*)(Vt + sw8(row, 4 * pp + (fq >> 1)) + (fq & 1) * 8);
          const uint2 h1 = *(const uint2*)(Vt + sw8(row, 4 * pp + 2 + (fq >> 1)) + (fq & 1) * 8);
          const bf16x8 va = mk8(h0.x, h0.y, h1.x, h1.y);
#pragma unroll
          for (int qi = 0; qi < 2; ++qi) o[e][qi] = mfma16(va, pb[qi][pp], o[e][qi]);
        }
    }
  }
  u16* Y = p.br + (size_t)3 * 32768 * LDB;
#pragma unroll
  for (int qi = 0; qi < 2; ++qi) {
    const float rl = 1.f / lrow[qi];
    const int tok = b * 2048 + qrow0 + qi * 16 + fr;
#pragma unroll
    for (int e = 0; e < 8; ++e) {
      *(uint2*)(Y + (size_t)tok * LDB + head * 128 + e * 16 + fq * 4) =
          make_uint2(pack2(o[e][qi][0] * rl, o[e][qi][1] * rl), pack2(o[e][qi][2] * rl, o[e][qi][3] * rl));
    }
  }
  __syncthreads();
}

DEV void lru_item(const Params& p, int layer, int b, int bl, int n, int eh, char* smem) {
  const int tid = ltid(), lane = tid & 63, wv = tid >> 6, fr = lane & 15, fq = lane >> 4;
  const u16* zb = p.zreg + (size_t)bl * 2048 * ZW;
  const int CX = 2048 + n * 64, CG = 2560 + n * 64 + eh * 32;
  char* WaT = smem;
  char* WxT = smem + 4096;
  char* XcB = smem + 8192;
  float* XcF = (float*)(smem + 16384);
  float* aS = (float*)(smem + 24576);
  float* segP = (float*)(smem + 32768);
  float* segH = segP + 256;
  u16* Y = p.br + (size_t)1 * 32768 * LDB;
  {
    const float* wa = p.lru_wa + ((size_t)layer * 8 + n) * 4096;
    const float* wx = p.lru_wx + ((size_t)layer * 8 + n) * 4096;
    for (int i = tid; i < 2048; i += 256) {
      const int d = i >> 5, e = i & 31;
      *(u16*)(WaT + sw8(e, d >> 3) + (d & 7) * 2) = f2bf(wa[d * 64 + eh * 32 + e]);
      *(u16*)(WxT + sw8(e, d >> 3) + (d & 7) * 2) = f2bf(wx[d * 64 + eh * 32 + e]);
    }
  }
  const int c = tid & 63, sg = tid >> 6;
  const int chb = layer * 512 + n * 64;
  const float cw0 = p.conv_w[(layer * 4 + 0) * 512 + n * 64 + c], cw1 = p.conv_w[(layer * 4 + 1) * 512 + n * 64 + c],
              cw2 = p.conv_w[(layer * 4 + 2) * 512 + n * 64 + c], cw3 = p.conv_w[(layer * 4 + 3) * 512 + n * 64 + c];
  const float cb = p.conv_b[chb + c];
  const int esub = wv & 1, tp = wv >> 1;
  float ba[4], bx[4], spl[4];
#pragma unroll
  for (int j = 0; j < 4; ++j) {
    const int e = chb + eh * 32 + esub * 16 + fq * 4 + j;
    ba[j] = p.lru_ba[e]; bx[j] = p.lru_bx[e];
    const float lam = p.lru_lam[e];
    spl[j] = fmaxf(-lam, 0.f) + log1pf(expf(-fabsf(lam)));
  }
  const int sc = tid & 31, ss = tid >> 5;
  float carry = 0.f;
  for (int chk = 0; chk < 32; ++chk) {
    const int t0 = chk * 64;
    {
      float xm3 = 0.f, xm2 = 0.f, xm1 = 0.f;
      const int tb = t0 + sg * 16;
      if (tb >= 3) {
        xm3 = bf2f(zb[(size_t)(tb - 3) * ZW + CX + c]);
        xm2 = bf2f(zb[(size_t)(tb - 2) * ZW + CX + c]);
        xm1 = bf2f(zb[(size_t)(tb - 1) * ZW + CX + c]);
      }
      float xin[16];
#pragma unroll
      for (int i = 0; i < 16; ++i) xin[i] = bf2f(zb[(size_t)(tb + i) * ZW + CX + c]);
#pragma unroll
      for (int i = 0; i < 16; ++i) {
        const float x0 = xin[i];
        const float xc = cb + cw0 * xm3 + cw1 * xm2 + cw2 * xm1 + cw3 * x0;
        xm3 = xm2; xm2 = xm1; xm1 = x0;
        const int tok = sg * 16 + i;
        if ((c >> 5) == eh) XcF[tok * 32 + (c & 31)] = xc;
        *(u16*)(XcB + sw8(tok, c >> 3) + (c & 7) * 2) = f2bf(xc);
      }
    }
    __syncthreads();
    {
      f32x4 ga[2], gx[2];
#pragma unroll
      for (int t = 0; t < 2; ++t) { ga[t] = f32x4{0.f, 0.f, 0.f, 0.f}; gx[t] = f32x4{0.f, 0.f, 0.f, 0.f}; }
#pragma unroll
      for (int ks = 0; ks < 2; ++ks) {
        const bf16x8 af = lds128(WaT + sw8(esub * 16 + fr, ks * 4 + fq));
        const bf16x8 xf = lds128(WxT + sw8(esub * 16 + fr, ks * 4 + fq));
#pragma unroll
        for (int t = 0; t < 2; ++t) {
          const bf16x8 tf = lds128(XcB + sw8((tp * 2 + t) * 16 + fr, ks * 4 + fq));
          ga[t] = mfma16(af, tf, ga[t]);
          gx[t] = mfma16(xf, tf, gx[t]);
        }
      }
#pragma unroll
      for (int t = 0; t < 2; ++t) {
        const int tok = (tp * 2 + t) * 16 + fr;
#pragma unroll
        for (int j = 0; j < 4; ++j) {
          const int e = esub * 16 + fq * 4 + j;
          const float r = sigmoidf_(ga[t][j] + ba[j]);
          const float ig = sigmoidf_(gx[t][j] + bx[j]);
          const float la = -8.f * r * spl[j];
          const float a = fexp(la);
          const float u = sqrtf(fmaxf(-expm1f(2.f * la), 0.f)) * ig * XcF[tok * 32 + e];
          aS[tok * 32 + e] = a;
          XcF[tok * 32 + e] = u;
        }
      }
    }
    __syncthreads();
    {
      float hl[8], pc[8];
      float hh = 0.f, pp = 1.f;
#pragma unroll
      for (int i = 0; i < 8; ++i) {
        const int tok = ss * 8 + i;
        const float a = aS[tok * 32 + sc], u = XcF[tok * 32 + sc];
        hh = a * hh + u; pp *= a;
        hl[i] = hh; pc[i] = pp;
      }
      segP[ss * 32 + sc] = pp; segH[ss * 32 + sc] = hh;
      float gte[8];
#pragma unroll
      for (int i = 0; i < 8; ++i) gte[i] = bf2f(zb[(size_t)(t0 + ss * 8 + i) * ZW + CG + sc]);
      __syncthreads();
      float cin = carry, call = carry;
#pragma unroll
      for (int s = 0; s < 8; ++s) {
        call = segP[s * 32 + sc] * call + segH[s * 32 + sc];
        if (s + 1 == ss) cin = call;
      }
      carry = call;
#pragma unroll
      for (int i = 0; i < 8; ++i) {
        const int t = t0 + ss * 8 + i;
        const float hv = hl[i] + pc[i] * cin;
        const float g = gte[i];
        const float ge = g * sigmoidf_(1.5957691216057308f * (g + 0.044715f * g * g * g));
        Y[(size_t)(b * 2048 + t) * LDB + n * 64 + eh * 32 + sc] = f2bf(hv * ge);
      }
    }
    __syncthreads();
  }
}

DEV void phase_branches(const Params& p, int layer, int half, char* smem) {
  unsigned* ctr = p.bar + 4 + 64 * (layer * 2 + half);
  int* s_item = (int*)(smem + SMEM_BYTES - 16);
  const int bid = blockIdx.x;
  for (int it = bid; it < 64; it += gridDim.x) {
    const int k = it & 31, bl = k >> 2, head = k & 3;
    if (it < 32) linattn_item<true>(p, layer, half * 8 + bl, bl, head, smem);
    else linattn_item<false>(p, layer, half * 8 + bl, bl, head, smem);
  }
  for (;;) {
    if (threadIdx.x == 0) *s_item = (int)atomicAdd(ctr, 1u) + 64;
    __syncthreads();
    const int it = *s_item;
    __syncthreads();
    if (it >= 704) break;
    if (it < 192) {
      const int idx = it - 64, bl = idx >> 4, n = (idx >> 1) & 7, eh = idx & 1;
      lru_item(p, layer, half * 8 + bl, bl, n, eh, smem);
    } else {
      const int idx = it - 192;
      const int qb = 15 - (idx >> 5), bh = idx & 31, bl = bh >> 2, head = bh & 3;
      attn_item(p, half * 8 + bl, bl, head, qb, smem);
    }
  }
}

constexpr int PH_PER_LAYER = 10;
constexpr int N_PHASES = 2 + 2 * PH_PER_LAYER;

DEV void run_phase(const Params& p, int ph, char* smem) {
  if (ph == 0) { phase_prep(p, smem); return; }
  if (ph == 1) { phase_lnmod0(p); return; }
  const int layer = (ph - 2) / PH_PER_LAYER, q = (ph - 2) % PH_PER_LAYER;
  const u16* W = p.Wb + (size_t)layer * WL;
  u16* merged = p.zreg;
  u16* ybuf = p.zreg + (size_t)32768 * LDH;
  u16* ubuf = p.zreg;
  u16* y2buf = p.zreg + (size_t)32768 * LDU;
  switch (q) {
    case 0: phase_zgemm(p, layer, 0, smem); break;
    case 1: phase_branches(p, layer, 0, smem); break;
    case 2: phase_zgemm(p, layer, 1, smem); break;
    case 3: phase_branches(p, layer, 1, smem); break;
    case 4: phase_merge(p, layer, merged, smem); break;
    case 5: phase_gemm<0>(W + OFF_WOUT, LDW1, merged, LDH, p.b_out + layer * 1024, ybuf, LDH, 1024, 1024, smem); break;
    case 6: phase_lnres(p, layer == 0 ? p.x : p.out, ybuf, layer, 0); break;
    case 7: phase_gemm<1>(W + OFF_W1, LDW1, p.h, LDH, p.b_ff1 + layer * 4096, ubuf, LDU, 4096, 1024, smem); break;
    case 8: phase_gemm<0>(W + OFF_W2, LDW4, ubuf, LDU, p.b_ff2 + layer * 1024, y2buf, LDH, 1024, 4096, smem); break;
    case 9: phase_lnres(p, p.out, y2buf, layer, 1); break;
  }
}

#define XB_XCNT(j)  (256  + 64 * (j))
#define XB_XSUB(j)  (1280 + 64 * (j))
#define XB_XGEN(j)  (2304 + 64 * (j))
#define XB_TOP      3328
#define XB_TOPGEN   3392
#define XCD_BAR_WORDS 3456
#define LAS __attribute__((address_space(3)))
DEV unsigned xb_ld(unsigned* p) { return __hip_atomic_load(p, __ATOMIC_RELAXED, __HIP_MEMORY_SCOPE_AGENT); }
DEV unsigned xb_add(unsigned* p, unsigned v) { return __hip_atomic_fetch_add(p, v, __ATOMIC_RELAXED, __HIP_MEMORY_SCOPE_AGENT); }
DEV unsigned xb_xcc_id() { return (unsigned)__builtin_amdgcn_s_getreg((3 << 11) | 20) & 0xFu; }

DEV void xcd_census(unsigned* bar, unsigned x, unsigned& nloc, unsigned& nx) {
  const unsigned G = gridDim.x;
  unsigned sum, cnt, mine;
  for (;;) {
    sum = 0u; cnt = 0u; mine = 0u;
#pragma unroll
    for (unsigned j = 0; j < 16; ++j) {
      const unsigned c = xb_ld(&bar[XB_XCNT(j)]);
      sum += c; cnt += (c > 0u) ? 1u : 0u; mine = (j == x) ? c : mine;
    }
    if (sum == G) break;
    __builtin_amdgcn_s_sleep(1);
  }
  nloc = mine > 0u ? mine : 1u; nx = cnt > 0u ? cnt : 1u;
}

DEV void xcd_barrier(unsigned* bar, unsigned x, volatile unsigned* st) {
  asm volatile("s_waitcnt vmcnt(0)" ::: "memory");
  __syncthreads();
  if (threadIdx.x == 0) {
    __builtin_amdgcn_s_waitcnt(0);
    unsigned nloc = st[0], nx = st[1];
    if (nloc == 0u) { xcd_census(bar, x, nloc, nx); st[0] = nloc; st[1] = nx; }
    const unsigned old = xb_add(&bar[XB_XSUB(x)], 1u);
    const unsigned gen = old / nloc;
    if (old + 1u == (gen + 1u) * nloc) {
      __builtin_amdgcn_fence(__ATOMIC_RELEASE, "agent");
      asm volatile("s_waitcnt vmcnt(0)" ::: "memory");
      const unsigned og = xb_add(&bar[XB_TOP], 1u);
      const unsigned tg = og / nx;
      if (og + 1u == (tg + 1u) * nx) xb_add(&bar[XB_TOPGEN], 1u);
      else { while (xb_ld(&bar[XB_TOPGEN]) == tg) __builtin_amdgcn_s_sleep(1); }
      __builtin_amdgcn_fence(__ATOMIC_ACQUIRE, "agent");
      xb_add(&bar[XB_XGEN(x)], 1u);
      asm volatile("s_waitcnt vmcnt(0)" ::: "memory");
    } else {
      while (xb_ld(&bar[XB_XGEN(x)]) == gen) __builtin_amdgcn_s_sleep(1);
      __builtin_amdgcn_fence(__ATOMIC_ACQUIRE, "agent");
      asm volatile("s_waitcnt vmcnt(0)" ::: "memory");
    }
  }
  __syncthreads();
}

#if MULTI_LAUNCH
__global__ void __launch_bounds__(256, 2) phase_kernel(Params p, int ph) {
  __shared__ __attribute__((aligned(16))) char smem[SMEM_BYTES];
  run_phase(p, ph, smem);
}
#else
__global__ void __launch_bounds__(256, 2) fwd_megakernel(Params p) {
  __shared__ __attribute__((aligned(16))) char smem[SMEM_BYTES];
  volatile unsigned* st = (volatile unsigned*)(smem + SMEM_BYTES - 32);
  const unsigned xcc = xb_xcc_id();
  if (threadIdx.x == 0) { st[0] = 0u; st[1] = 0u; (void)xb_add(&p.bar[XB_XCNT(xcc)], 1u); }
  __syncthreads();
  if (p.bar == nullptr) cg::this_grid().sync();
#define PH(n) run_phase(p, n, smem); xcd_barrier(p.bar, xcc, st);
  PH(0)
  PH(1) PH(2) PH(3) PH(4) PH(5) PH(6) PH(7) PH(8) PH(9) PH(10) PH(11)
  PH(12) PH(13) PH(14) PH(15) PH(16) PH(17) PH(18) PH(19) PH(20)
  run_phase(p, 21, smem);
#undef PH
}
#endif

extern "C" void kernel_launch(void* const* d_in, const int* in_sizes, int n_in, void* d_out, int out_size, void* d_ws,
                              size_t ws_size, hipStream_t stream) {
  Params p{};
  p.x = (const float*)d_in[0]; p.c = (const float*)d_in[1]; p.pos = (const int*)d_in[2];
  p.w_ada = (const float*)d_in[3]; p.b_ada = (const float*)d_in[4]; p.w_in = (const float*)d_in[5];
  p.b_in = (const float*)d_in[6]; p.m_norm = (const float*)d_in[7]; p.conv_w = (const float*)d_in[8];
  p.conv_b = (const float*)d_in[9]; p.lru_wa = (const float*)d_in[10]; p.lru_ba = (const float*)d_in[11];
  p.lru_wx = (const float*)d_in[12]; p.lru_bx = (const float*)d_in[13]; p.lru_lam = (const float*)d_in[14];
  p.r_norm = (const float*)d_in[15]; p.w_br = (const float*)d_in[16]; p.w_out = (const float*)d_in[17];
  p.b_out = (const float*)d_in[18]; p.ln1_g = (const float*)d_in[19]; p.ln1_b = (const float*)d_in[20];
  p.w_ff1 = (const float*)d_in[21]; p.b_ff1 = (const float*)d_in[22]; p.w_ff2 = (const float*)d_in[23];
  p.b_ff2 = (const float*)d_in[24]; p.ln2_g = (const float*)d_in[25]; p.ln2_b = (const float*)d_in[26];
  p.out = (float*)d_out;
  char* ws = (char*)d_ws;
  size_t off = 0;
  p.Wb = (u16*)(ws + off); off += 2 * WL * 2;
  p.h = (u16*)(ws + off); off += (size_t)32768 * LDH * 2;
  p.zreg = (u16*)(ws + off); off += (size_t)16384 * ZW * 2;
  p.br = (u16*)(ws + off); off += (size_t)4 * 32768 * LDB * 2;
  p.small = (float*)(ws + off); off += (size_t)32768 * 16 * 4;
  p.mod = (float*)(ws + off); off += (size_t)2 * 16 * 6144 * 4;
  p.h0f = (float*)(ws + off); off += (size_t)16 * 1024 * 4;
  p.qk0 = (float*)(ws + off); off += (size_t)16 * 2048 * 4;
  p.bar = (unsigned*)(ws + off); off += XCD_BAR_WORDS * 4;
  hipMemsetAsync(p.bar, 0, XCD_BAR_WORDS * 4, stream);
  static int grid_blocks = 0;
  if (!grid_blocks) {
    int dev = 0, cus = 0, per_cu = 0;
    hipGetDevice(&dev);
    hipDeviceGetAttribute(&cus, hipDeviceAttributeMultiprocessorCount, dev);
#if MULTI_LAUNCH
    hipOccupancyMaxActiveBlocksPerMultiprocessor(&per_cu, phase_kernel, 256, 0);
#else
    hipOccupancyMaxActiveBlocksPerMultiprocessor(&per_cu, fwd_megakernel, 256, 0);
#endif
    if (per_cu < 1) per_cu = 1;
    if (per_cu > 2) per_cu = 2;
    grid_blocks = cus * per_cu;
  }
#if MULTI_LAUNCH
  for (int ph = 0; ph < N_PHASES; ++ph) hipLaunchKernelGGL(phase_kernel, dim3(grid_blocks), dim3(256), 0, stream, p, ph);
#else
  void* args[] = {&p};
  hipError_t e = hipLaunchCooperativeKernel((void*)fwd_megakernel, dim3(grid_blocks), dim3(256), args, 0, stream);
  if (e != hipSuccess) fprintf(stderr, "cooperative launch failed: %s (grid %d)\n", hipGetErrorString(e), grid_blocks);
#endif
}
```

```cpp
#include <hip/hip_runtime.h>
#include <hip/hip_cooperative_groups.h>
#include <cstdio>
namespace cg = cooperative_groups;

typedef unsigned short u16;
typedef unsigned int u32;
typedef __attribute__((ext_vector_type(8))) short bf16x8;
typedef __attribute__((ext_vector_type(4))) float f32x4;

#define DEV __device__ __forceinline__
__device__ __forceinline__ int threadIdx_x_raw() { return (int)threadIdx.x; }

#ifndef MULTI_LAUNCH
#define MULTI_LAUNCH 0
#endif

constexpr int SMEM_BYTES = 80384;
constexpr int BF = 256, BTK = 128;
constexpr int ZW = 6720;
constexpr int LDH = 1088;
constexpr int LDU = 4160;
constexpr int LDB = 544;
constexpr int LDW1 = 1088, LDW5 = 544, LDW4 = 4160;
constexpr int NIN = 10764;
constexpr int GATE_ROW0 = 6784;
constexpr size_t OFF_WIN = 0, OFF_WBR = OFF_WIN + (size_t)10880 * LDW1, OFF_WOUT = OFF_WBR + (size_t)4 * 1024 * LDW5,
                 OFF_W1 = OFF_WOUT + (size_t)1024 * LDW1, OFF_W2 = OFF_W1 + (size_t)4096 * LDW1,
                 WL = OFF_W2 + (size_t)1024 * LDW4;
constexpr float ALPHA = 1.4142135623730951f;
constexpr float LOG2E = 1.4426950408889634f;

struct Params {
  const float *x, *c; const int* pos;
  const float *w_ada, *b_ada, *w_in, *b_in, *m_norm, *conv_w, *conv_b, *lru_wa, *lru_ba, *lru_wx, *lru_bx, *lru_lam,
      *r_norm, *w_br, *w_out, *b_out, *ln1_g, *ln1_b, *w_ff1, *b_ff1, *w_ff2, *b_ff2, *ln2_g, *ln2_b;
  float* out;
  u16* Wb; u16* h; u16* zreg; u16* br; float* small; float* mod; float* h0f; float* qk0; unsigned* bar;
};

typedef __attribute__((ext_vector_type(4))) unsigned int u32x4;
DEV bf16x8 mk8(u32 a, u32 b, u32 c, u32 d) { u32x4 t = {a, b, c, d}; return __builtin_bit_cast(bf16x8, t); }
DEV u32 wsel(u32x4 q, int i) { return q[i]; }

DEV int ltid() { int t = threadIdx_x_raw(); asm volatile("" : "+v"(t)); return t; }
typedef __attribute__((ext_vector_type(2))) __bf16 bf16v2;
typedef __attribute__((ext_vector_type(2))) float f32v2;
DEV u32 pack2(float a, float b) { f32v2 v = {a, b}; return __builtin_bit_cast(u32, __builtin_convertvector(v, bf16v2)); }
DEV u16 f2bf(float f) { return (u16)(pack2(f, 0.f) & 0xffffu); }
DEV float bf2f(u32 h) { return __uint_as_float(h << 16); }
DEV float bflo(u32 w) { return __uint_as_float(w << 16); }
DEV float bfhi(u32 w) { return __uint_as_float(w & 0xffff0000u); }
DEV f32x4 mfma16(bf16x8 a, bf16x8 b, f32x4 c) { return __builtin_amdgcn_mfma_f32_16x16x32_bf16(a, b, c, 0, 0, 0); }
DEV float fexp2(float x) { return __builtin_amdgcn_exp2f(x); }
DEV float fexp(float x) { return __builtin_amdgcn_exp2f(x * LOG2E); }
DEV float frcp(float x) { return __builtin_amdgcn_rcpf(x); }
DEV float sigmoidf_(float x) { return frcp(1.f + fexp(-x)); }
DEV float logsigf_(float x) { return fminf(x, 0.f) - log1pf(expf(-fabsf(x))); }
DEV float wave_sum(float v) {
#pragma unroll
  for (int m = 32; m >= 1; m >>= 1) v += __shfl_xor(v, m);
  return v;
}
DEV int sw8(int row, int chunk) { return row * 128 + ((chunk ^ ((row >> 1) & 7)) << 4); }
DEV int sw16(int row, int chunk) { return row * 256 + ((chunk ^ (row & 15)) << 4); }
DEV bf16x8 lds128(const char* p) { return *(const bf16x8*)p; }
DEV float4 ld_nt16(const float* p) { f32x4 v = __builtin_nontemporal_load((const f32x4*)p); return make_float4(v[0], v[1], v[2], v[3]); }
DEV void st_nt16(float* p, float a, float b, float c, float d) { f32x4 v = {a, b, c, d}; __builtin_nontemporal_store(v, (f32x4*)p); }

struct GOp { const u16* W; int ldw; const u16* X; int ldx; int K; };
template <int FT, int TT>
struct GPipe { u32x4 rw[FT / 32], rx[TT / 32]; };

#define G_LOAD(RW, RX, WP, LDW, XP, LDX)                                                           \
  {                                                                                                \
    _Pragma("unroll") for (int i = 0; i < WI; ++i) RW[i] = *(const u32x4*)((WP) + (size_t)i * 32 * (LDW)); \
    _Pragma("unroll") for (int i = 0; i < XI; ++i) RX[i] = *(const u32x4*)((XP) + (size_t)i * 32 * (LDX)); \
  }
#define G_STORE(ST, RW, RX)                                                                        \
  {                                                                                                \
    _Pragma("unroll") for (int i = 0; i < WI; ++i) *(u32x4*)(ST + sw8(lr + i * 32, lc)) = RW[i];  \
    _Pragma("unroll") for (int i = 0; i < XI; ++i) *(u32x4*)(ST + WBYTES + sw8(lr + i * 32, lc)) = RX[i]; \
  }
#define G_COMPUTE(ST)                                                                              \
  {                                                                                                \
    _Pragma("unroll") for (int ks = 0; ks < 2; ++ks) {                                             \
      bf16x8 bx[XI];                                                                               \
      _Pragma("unroll") for (int i = 0; i < XI; ++i) bx[i] = lds128(ST + WBYTES + sw8(wt * (TT / 2) + i * 16 + fr, ks * 4 + fq)); \
      _Pragma("unroll") for (int ah = 0; ah < WI; ah += 4) {                                       \
        bf16x8 af[4];                                                                              \
        _Pragma("unroll") for (int i = 0; i < 4; ++i) af[i] = lds128(ST + sw8(wf * (FT / 2) + (ah + i) * 16 + fr, ks * 4 + fq)); \
        _Pragma("unroll") for (int a = 0; a < 4; ++a)                                              \
          _Pragma("unroll") for (int b = 0; b < XI; ++b) acc[ah + a][b] = mfma16(af[a], bx[b], acc[ah + a][b]); \
      }                                                                                            \
    }                                                                                              \
  }

template <int FT, int TT>
DEV void gemm_prime(GPipe<FT, TT>& pp, const GOp& op, char* smem) {
  constexpr int WI = FT / 32, XI = TT / 32;
  constexpr int WBYTES = FT * 128;
  const int tid = ltid();
  const int lr = tid >> 3, lc = tid & 7;
  const u16* wp = op.W + (size_t)lr * op.ldw + lc * 8;
  const u16* xp = op.X + (size_t)lr * op.ldx + lc * 8;
  __syncthreads();
  G_LOAD(pp.rw, pp.rx, wp, op.ldw, xp, op.ldx);
  G_STORE(smem, pp.rw, pp.rx);
  __syncthreads();
}

template <int FT, int TT>
DEV void gemm_mainloop(GPipe<FT, TT>& pp, const GOp& op, const GOp& nx, f32x4 (&acc)[FT / 32][TT / 32], char* smem) {
  constexpr int WI = FT / 32, XI = TT / 32;
  constexpr int WBYTES = FT * 128, XBYTES = TT * 128, STAGE = WBYTES + XBYTES;
  const int tid = ltid(), lane = tid & 63, wv = tid >> 6;
  const int wf = wv >> 1, wt = wv & 1, fr = lane & 15, fq = lane >> 4;
  const int lr = tid >> 3, lc = tid & 7;
  const u16* wp = op.W + (size_t)lr * op.ldw + lc * 8;
  const u16* xp = op.X + (size_t)lr * op.ldx + lc * 8;
  const u16* nwp = nx.W + (size_t)lr * nx.ldw + lc * 8;
  const u16* nxp = nx.X + (size_t)lr * nx.ldx + lc * 8;
  char* st0 = smem;
  char* st1 = smem + STAGE;
  const int nk = op.K >> 6;
  for (int kt = 0; kt < nk; kt += 2) {
    G_LOAD(pp.rw, pp.rx, wp + (kt + 1) * 64, op.ldw, xp + (kt + 1) * 64, op.ldx);
    G_COMPUTE(st0);
    G_STORE(st1, pp.rw, pp.rx);
    __syncthreads();
    {
      const bool cur = (kt + 2 < nk);
      const u16* a = cur ? wp + (kt + 2) * 64 : nwp;
      const u16* b = cur ? xp + (kt + 2) * 64 : nxp;
      const int la = cur ? op.ldw : nx.ldw, lb = cur ? op.ldx : nx.ldx;
      G_LOAD(pp.rw, pp.rx, a, la, b, lb);
    }
    G_COMPUTE(st1);
    G_STORE(st0, pp.rw, pp.rx);
    __syncthreads();
  }
}
template <int FT, int TT>
DEV void gemm_mainloop_sb(GPipe<FT, TT>& pp, const GOp& op, const GOp& nx, f32x4 (&acc)[FT / 32][TT / 32], char* smem) {
  constexpr int WI = FT / 32, XI = TT / 32;
  constexpr int WBYTES = FT * 128;
  const int tid = ltid(), lane = tid & 63, wv = tid >> 6;
  const int wf = wv >> 1, wt = wv & 1, fr = lane & 15, fq = lane >> 4;
  const int lr = tid >> 3, lc = tid & 7;
  const u16* wp = op.W + (size_t)lr * op.ldw + lc * 8;
  const u16* xp = op.X + (size_t)lr * op.ldx + lc * 8;
  const u16* nwp = nx.W + (size_t)lr * nx.ldw + lc * 8;
  const u16* nxp = nx.X + (size_t)lr * nx.ldx + lc * 8;
  char* st0 = smem;
  const int nk = op.K >> 6;
  for (int kt = 0; kt < nk; ++kt) {
    {
      const bool cur = (kt + 1 < nk);
      const u16* a = cur ? wp + (kt + 1) * 64 : nwp;
      const u16* b = cur ? xp + (kt + 1) * 64 : nxp;
      const int la = cur ? op.ldw : nx.ldw, lb = cur ? op.ldx : nx.ldx;
      G_LOAD(pp.rw, pp.rx, a, la, b, lb);
    }
    G_COMPUTE(st0);
    __syncthreads();
    G_STORE(st0, pp.rw, pp.rx);
    __syncthreads();
  }
}
#undef G_LOAD
#undef G_STORE
#undef G_COMPUTE

DEV void tile_map(int i, int TM, int TN, int& tm, int& tn) {
  const int xcd = i & 7, j = i >> 3;
  const int tmx = TM >> 3, per = 8 * TN;
  const int g = j / per, r = j - g * per;
  tn = r >> 3;
  tm = xcd * tmx + g * 8 + (r & 7);
}

DEV int winmap(int n) {
  if (n < 2048) return n;
  if (n < 6656) return n + 8;
  if (n < 6664) return 2048 + (n - 6656);
  if (n < 6668) return n;
  if (n < GATE_ROW0) return -1;
  return 6668 + (n - GATE_ROW0);
}

DEV void transpose_tile(const float* __restrict__ src, int ld_src, u16* __restrict__ dst, int ld_dst, int k0, int n0,
                        bool win, char* smem) {
  float* tile = (float*)smem;
  const int tid = ltid();
  {
    const int nn = tid & 127;
    const int col = win ? winmap(n0 + nn) : (n0 + nn);
    float v[32];
#pragma unroll
    for (int r = 0; r < 32; ++r) {
      const int kk = r * 2 + (tid >> 7);
      v[r] = (col >= 0) ? src[(size_t)(k0 + kk) * ld_src + col] : 0.f;
    }
#pragma unroll
    for (int r = 0; r < 32; ++r) tile[(r * 2 + (tid >> 7)) * 129 + nn] = v[r];
  }
  __syncthreads();
  {
    const int nn = tid >> 1, kq = (tid & 1) * 32;
    u32 w[16];
#pragma unroll
    for (int i = 0; i < 16; ++i) w[i] = pack2(tile[(kq + 2 * i) * 129 + nn], tile[(kq + 2 * i + 1) * 129 + nn]);
    u16* d = dst + (size_t)(n0 + nn) * ld_dst + k0 + kq;
#pragma unroll
    for (int i = 0; i < 4; ++i) *(uint4*)(d + 8 * i) = make_uint4(w[4 * i], w[4 * i + 1], w[4 * i + 2], w[4 * i + 3]);
  }
  __syncthreads();
}

template <bool SILU>
DEV void gemv16_task(const float* __restrict__ A, const float* __restrict__ W, size_t ldw, const float* __restrict__ bias,
                     float* __restrict__ out, int ldo, char* smem) {
  float* cs = (float*)smem;
  const int tid = ltid();
  for (int i = tid; i < 16384; i += 256) {
    const float v = A[i];
    cs[i] = SILU ? v / (1.f + expf(-v)) : v;
  }
  __syncthreads();
  const int ks = tid >> 5, cc = tid & 31;
  const float* w = W + (size_t)(ks * 128) * ldw + cc;
  float acc[16];
#pragma unroll
  for (int b = 0; b < 16; ++b) acc[b] = 0.f;
#pragma unroll 8
  for (int k = 0; k < 128; ++k) {
    const float wv = w[(size_t)k * ldw];
    const float* cp = cs + ks * 128 + k;
#pragma unroll
    for (int b = 0; b < 16; ++b) acc[b] += cp[b * 1024] * wv;
  }
  __syncthreads();
  float* red = (float*)smem;
#pragma unroll
  for (int b = 0; b < 16; ++b) red[(ks * 16 + b) * 32 + cc] = acc[b];
  __syncthreads();
  for (int o = tid; o < 512; o += 256) {
    const int b = o >> 5, c = o & 31;
    float s = 0.f;
#pragma unroll
    for (int q = 0; q < 8; ++q) s += red[(q * 16 + b) * 32 + c];
    out[(size_t)b * ldo + c] = s + bias[c];
  }
  __syncthreads();
}

DEV void mod_task(const Params& p, int m, char* smem) {
  const int layer = m / 192, cb = (m % 192) * 32;
  gemv16_task<true>(p.c, p.w_ada + (size_t)layer * 1024 * 6144 + cb, 6144, p.b_ada + layer * 6144 + cb,
                    p.mod + (size_t)layer * 16 * 6144 + cb, 6144, smem);
}

DEV void qk0_task(const Params& p, int layer, int j, char* smem) {
  const int grp = j >> 4, c0 = (j & 15) * 32;
  const int ocol = (grp == 0 ? 0 : (grp == 1 ? 512 : (grp == 2 ? 3080 : 3592))) + c0;
  gemv16_task<false>(p.h0f, p.w_in + (size_t)layer * 1024 * NIN + ocol, NIN, p.b_in + (size_t)layer * NIN + ocol,
                     p.qk0 + grp * 512 + c0, 2048, smem);
}

DEV void phase_prep(const Params& p, char* smem) {
  constexpr int NMOD = 384, PER_LAYER = 1360 + 256 + 128 + 512 + 512;
  unsigned* ctr = p.bar + 36;
  int* s_item = (int*)(smem + SMEM_BYTES - 16);
  for (;;) {
    if (threadIdx.x == 0) *s_item = (int)atomicAdd(ctr, 1u);
    __syncthreads();
    const int t = *s_item;
    __syncthreads();
    if (t >= NMOD + 2 * PER_LAYER) break;
    if (t < NMOD) { mod_task(p, t, smem); continue; }
    const int tt = t - NMOD;
    const int layer = tt / PER_LAYER;
    int r = tt - layer * PER_LAYER;
    u16* W = p.Wb + (size_t)layer * WL;
    if (r < 1360) {
      transpose_tile(p.w_in + (size_t)layer * 1024 * NIN, NIN, W + OFF_WIN, LDW1, (r & 15) * 64, (r >> 4) * 128, true, smem);
    } else if (r < 1616) {
      r -= 1360;
      const int n = r >> 6, r3 = r & 63;
      transpose_tile(p.w_br + ((size_t)layer * 4 + n) * 512 * 1024, 1024, W + OFF_WBR + (size_t)n * 1024 * LDW5, LDW5,
                     (r3 & 7) * 64, (r3 >> 3) * 128, false, smem);
    } else if (r < 1744) {
      r -= 1616;
      transpose_tile(p.w_out + (size_t)layer * 1024 * 1024, 1024, W + OFF_WOUT, LDW1, (r & 15) * 64, (r >> 4) * 128, false, smem);
    } else if (r < 2256) {
      r -= 1744;
      transpose_tile(p.w_ff1 + (size_t)layer * 1024 * 4096, 4096, W + OFF_W1, LDW1, (r & 15) * 64, (r >> 4) * 128, false, smem);
    } else {
      r -= 2256;
      transpose_tile(p.w_ff2 + (size_t)layer * 4096 * 1024, 1024, W + OFF_W2, LDW4, (r & 63) * 64, (r >> 6) * 128, false, smem);
    }
  }
}

DEV void ln_stats(const float (&v)[16], float& mean, float& rstd) {
  float s = 0.f;
#pragma unroll
  for (int i = 0; i < 16; ++i) s += v[i];
  mean = wave_sum(s) * (1.f / 1024.f);
  float q = 0.f;
#pragma unroll
  for (int i = 0; i < 16; ++i) { const float d = v[i] - mean; q += d * d; }
  rstd = rsqrtf(wave_sum(q) * (1.f / 1024.f) + 1e-5f);
}

DEV void mod_store_h(const float (&xn)[16], const float* modb, int shoff, int scoff, u16* hrow, int lane, float* h0row) {
  float mean, rstd;
  ln_stats(xn, mean, rstd);
#pragma unroll
  for (int i = 0; i < 4; ++i) {
    const int col = i * 256 + lane * 4;
    const float4 sh = *(const float4*)(modb + shoff + col);
    const float4 sc = *(const float4*)(modb + scoff + col);
    const float h0 = (xn[i * 4 + 0] - mean) * rstd * (1.f + sc.x) + sh.x;
    const float h1 = (xn[i * 4 + 1] - mean) * rstd * (1.f + sc.y) + sh.y;
    const float h2 = (xn[i * 4 + 2] - mean) * rstd * (1.f + sc.z) + sh.z;
    const float h3 = (xn[i * 4 + 3] - mean) * rstd * (1.f + sc.w) + sh.w;
    *(uint2*)(hrow + col) = make_uint2(pack2(h0, h1), pack2(h2, h3));
    if (h0row) *(float4*)(h0row + col) = make_float4(h0, h1, h2, h3);
  }
}

DEV void phase_lnmod0(const Params& p) {
  const int lane = ltid() & 63, wv = ltid() >> 6;
  for (int row = blockIdx.x * 4 + wv; row < 32768; row += gridDim.x * 4) {
    float v[16];
#pragma unroll
    for (int i = 0; i < 4; ++i) {
      const float4 xv = ld_nt16(p.x + (size_t)row * 1024 + i * 256 + lane * 4);
      v[i * 4 + 0] = xv.x; v[i * 4 + 1] = xv.y; v[i * 4 + 2] = xv.z; v[i * 4 + 3] = xv.w;
    }
    const float* modb = p.mod + (size_t)(0 * 16 + (row >> 11)) * 6144;
    mod_store_h(v, modb, 0, 1024, p.h + (size_t)row * LDH, lane, (row & 2047) == 0 ? p.h0f + (row >> 11) * 1024 : nullptr);
  }
}

DEV void phase_lnres(const Params& p, const float* xin, const u16* y, int layer, int sub) {
  const int lane = ltid() & 63, wv = ltid() >> 6;
  const int goff = sub == 0 ? 2048 : 5120;
  const float* gam = (sub == 0 ? p.ln1_g : p.ln2_g) + layer * 1024;
  const float* bet = (sub == 0 ? p.ln1_b : p.ln2_b) + layer * 1024;
  const bool has_next = (sub == 0) || (layer + 1 < 2);
  const int nlayer = sub == 0 ? layer : layer + 1;
  const int shoff = sub == 0 ? 3072 : 0, scoff = sub == 0 ? 4096 : 1024;
  const int stride = gridDim.x * 4;
  int row = blockIdx.x * 4 + wv;
  float4 xq[4]; uint2 yq[4];
  if (row < 32768) {
#pragma unroll
    for (int i = 0; i < 4; ++i) {
      xq[i] = ld_nt16(xin + (size_t)row * 1024 + i * 256 + lane * 4);
      yq[i] = *(const uint2*)(y + (size_t)row * LDH + i * 256 + lane * 4);
    }
  }
  for (; row < 32768; row += stride) {
    const int b = row >> 11;
    const float* modb = p.mod + (size_t)(layer * 16 + b) * 6144;
    float4 xn[4]; uint2 yn[4];
    {
      const int nrow = (row + stride < 32768) ? row + stride : row;
#pragma unroll
      for (int i = 0; i < 4; ++i) {
        xn[i] = ld_nt16(xin + (size_t)nrow * 1024 + i * 256 + lane * 4);
        yn[i] = *(const uint2*)(y + (size_t)nrow * LDH + i * 256 + lane * 4);
      }
    }
    float v[16];
#pragma unroll
    for (int i = 0; i < 4; ++i) {
      const int col = i * 256 + lane * 4;
      const float4 xv = xq[i];
      const uint2 yv = yq[i];
      const float4 gv = *(const float4*)(modb + goff + col);
      v[i * 4 + 0] = ALPHA * xv.x + (1.f + gv.x) * bflo(yv.x);
      v[i * 4 + 1] = ALPHA * xv.y + (1.f + gv.y) * bfhi(yv.x);
      v[i * 4 + 2] = ALPHA * xv.z + (1.f + gv.z) * bflo(yv.y);
      v[i * 4 + 3] = ALPHA * xv.w + (1.f + gv.w) * bfhi(yv.y);
    }
    float mean, rstd;
    ln_stats(v, mean, rstd);
#pragma unroll
    for (int i = 0; i < 4; ++i) {
      const int col = i * 256 + lane * 4;
      const float4 ga = *(const float4*)(gam + col);
      const float4 be = *(const float4*)(bet + col);
      v[i * 4 + 0] = (v[i * 4 + 0] - mean) * rstd * ga.x + be.x;
      v[i * 4 + 1] = (v[i * 4 + 1] - mean) * rstd * ga.y + be.y;
      v[i * 4 + 2] = (v[i * 4 + 2] - mean) * rstd * ga.z + be.z;
      v[i * 4 + 3] = (v[i * 4 + 3] - mean) * rstd * ga.w + be.w;
      st_nt16(p.out + (size_t)row * 1024 + col, v[i * 4 + 0], v[i * 4 + 1], v[i * 4 + 2], v[i * 4 + 3]);
    }
    if (has_next) {
      const float* modn = p.mod + (size_t)(nlayer * 16 + b) * 6144;
      mod_store_h(v, modn, shoff, scoff, p.h + (size_t)row * LDH, lane,
                  (sub == 1 && (row & 2047) == 0) ? p.h0f + (row >> 11) * 1024 : nullptr);
    }
#pragma unroll
    for (int i = 0; i < 4; ++i) { xq[i] = xn[i]; yq[i] = yn[i]; }
  }
}

DEV void phase_zgemm(const Params& p, int layer, int half, char* smem) {
  const u16* WinT = p.Wb + (size_t)layer * WL + OFF_WIN;
  const u16* hb = p.h + (size_t)half * 16384 * LDH;
  const float* bin = p.b_in + (size_t)layer * NIN;
  const int lane = ltid() & 63, wv = ltid() >> 6, wf = wv >> 1, wt = wv & 1, fr = lane & 15, fq = lane >> 4;
  constexpr int TM = 16384 / BTK, TNZ = 6656 / BF, TN = TNZ + 1;
  GPipe<BF, BTK> pp;
  bool primed = false;
  for (int i = blockIdx.x; i < TM * TN; i += gridDim.x) {
    int tm, tn;
    tile_map(i, TM, TN, tm, tn);
    const GOp op{WinT + (size_t)tn * BF * LDW1, LDW1, hb + (size_t)tm * BTK * LDH, LDH, 1024};
    GOp nx = op;
    if (i + (int)gridDim.x < TM * TN) {
      int tm2, tn2;
      tile_map(i + gridDim.x, TM, TN, tm2, tn2);
      nx.W = WinT + (size_t)tn2 * BF * LDW1; nx.X = hb + (size_t)tm2 * BTK * LDH;
    }
    if (!primed) { gemm_prime<BF, BTK>(pp, op, smem); primed = true; }
    f32x4 acc[BF / 32][BTK / 32];
#pragma unroll
    for (int a = 0; a < BF / 32; ++a)
#pragma unroll
      for (int b = 0; b < BTK / 32; ++b) acc[a][b] = f32x4{0.f, 0.f, 0.f, 0.f};
    gemm_mainloop_sb<BF, BTK>(pp, op, nx, acc, smem);
    if (tn < TNZ) {
#pragma unroll
      for (int a = 0; a < BF / 32; ++a) {
        const int feat = tn * BF + wf * (BF / 2) + a * 16 + fq * 4;
        const int oc = feat < 2048 ? feat : feat + 8;
        const float b0 = bin[oc], b1 = bin[oc + 1], b2 = bin[oc + 2], b3 = bin[oc + 3];
#pragma unroll
        for (int b = 0; b < BTK / 32; ++b) {
          const int tok = tm * BTK + wt * (BTK / 2) + b * 16 + fr;
          *(uint2*)(p.zreg + (size_t)tok * ZW + feat) =
              make_uint2(pack2(acc[a][b][0] + b0, acc[a][b][1] + b1), pack2(acc[a][b][2] + b2, acc[a][b][3] + b3));
        }
      }
    } else if (wf == 0) {
      const int c = fq * 4;
      float bb[4];
#pragma unroll
      for (int j = 0; j < 4; ++j) {
        const int cc = c + j;
        bb[j] = cc < 8 ? bin[2048 + cc] : (cc < 12 ? bin[6664 + cc - 8] : 0.f);
      }
#pragma unroll
      for (int b = 0; b < BTK / 32; ++b) {
        const int tok = half * 16384 + tm * BTK + wt * (BTK / 2) + b * 16 + fr;
        *(float4*)(p.small + (size_t)tok * 16 + c) =
            make_float4(acc[0][b][0] + bb[0], acc[0][b][1] + bb[1], acc[0][b][2] + bb[2], acc[0][b][3] + bb[3]);
      }
    }
  }
  if (half == 0) {
    for (int j = (int)gridDim.x - 1 - (int)blockIdx.x; j < 64; j += gridDim.x) {
      __syncthreads();
      qk0_task(p, layer, j, smem);
    }
  }
}

template <int MODE>
DEV void phase_gemm(const u16* Wt, int ldw, const u16* X, int ldx, const float* bias, u16* out, int ldo, int N, int K, char* smem) {
  const int lane = ltid() & 63, wv = ltid() >> 6, wf = wv >> 1, wt = wv & 1, fr = lane & 15, fq = lane >> 4;
  const int TM = 32768 / BTK, TN = N / BF;
  GPipe<BF, BTK> pp;
  bool primed = false;
  for (int i = blockIdx.x; i < TM * TN; i += gridDim.x) {
    int tm, tn;
    tile_map(i, TM, TN, tm, tn);
    const GOp op{Wt + (size_t)tn * BF * ldw, ldw, X + (size_t)tm * BTK * ldx, ldx, K};
    GOp nx = op;
    if (i + (int)gridDim.x < TM * TN) {
      int tm2, tn2;
      tile_map(i + gridDim.x, TM, TN, tm2, tn2);
      nx.W = Wt + (size_t)tn2 * BF * ldw; nx.X = X + (size_t)tm2 * BTK * ldx;
    }
    if (!primed) { gemm_prime<BF, BTK>(pp, op, smem); primed = true; }
    f32x4 acc[BF / 32][BTK / 32];
#pragma unroll
    for (int a = 0; a < BF / 32; ++a)
#pragma unroll
      for (int b = 0; b < BTK / 32; ++b) acc[a][b] = f32x4{0.f, 0.f, 0.f, 0.f};
    gemm_mainloop_sb<BF, BTK>(pp, op, nx, acc, smem);
#pragma unroll
    for (int a = 0; a < BF / 32; ++a) {
      const int feat = tn * BF + wf * (BF / 2) + a * 16 + fq * 4;
      const float4 bv = *(const float4*)(bias + feat);
#pragma unroll
      for (int b = 0; b < BTK / 32; ++b) {
        const int tok = tm * BTK + wt * (BTK / 2) + b * 16 + fr;
        float v0 = acc[a][b][0] + bv.x, v1 = acc[a][b][1] + bv.y, v2 = acc[a][b][2] + bv.z, v3 = acc[a][b][3] + bv.w;
        if (MODE == 1) {
          v0 = fmaxf(v0, 0.f); v0 *= v0; v1 = fmaxf(v1, 0.f); v1 *= v1;
          v2 = fmaxf(v2, 0.f); v2 *= v2; v3 = fmaxf(v3, 0.f); v3 *= v3;
        }
        *(uint2*)(out + (size_t)tok * ldo + feat) = make_uint2(pack2(v0, v1), pack2(v2, v3));
      }
    }
  }
}

DEV void phase_merge(const Params& p, int layer, u16* merged, char* smem) {
  const u16* W = p.Wb + (size_t)layer * WL;
  const float* bg = p.b_in + (size_t)layer * NIN + 6668;
  const int lane = ltid() & 63, wv = ltid() >> 6, wf = wv >> 1, wt = wv & 1, fr = lane & 15, fq = lane >> 4;
  constexpr int TM = 256, TN = 8;
  GPipe<128, 128> pp;
  bool primed = false;
  for (int i = blockIdx.x; i < TM * TN; i += gridDim.x) {
    int tm, tn;
    tile_map(i, TM, TN, tm, tn);
    int tm2 = tm, tn2 = tn;
    const bool has_next = (i + (int)gridDim.x < TM * TN);
    if (has_next) tile_map(i + gridDim.x, TM, TN, tm2, tn2);
    u32 pm[4][4][2];
#pragma unroll
    for (int a = 0; a < 4; ++a)
#pragma unroll
      for (int b = 0; b < 4; ++b) { pm[a][b][0] = 0u; pm[a][b][1] = 0u; }
    for (int n = 0; n < 4; ++n) {
      const GOp opg{W + OFF_WIN + (size_t)(GATE_ROW0 + n * 1024 + tn * 128) * LDW1, LDW1, p.h + (size_t)tm * 128 * LDH, LDH, 1024};
      const GOp opb{W + OFF_WBR + (size_t)n * 1024 * LDW5 + (size_t)(tn * 128) * LDW5, LDW5,
                    p.br + (size_t)n * 32768 * LDB + (size_t)tm * 128 * LDB, LDB, 512};
      const int nn = (n + 1) & 3, tmn = (n < 3) ? tm : tm2, tnn = (n < 3) ? tn : tn2;
      GOp opn{W + OFF_WIN + (size_t)(GATE_ROW0 + nn * 1024 + tnn * 128) * LDW1, LDW1, p.h + (size_t)tmn * 128 * LDH, LDH, 1024};
      if (n == 3 && !has_next) opn = opb;
      if (!primed) { gemm_prime<128, 128>(pp, opg, smem); primed = true; }
      u32 gp[4][4][2];
      {
        f32x4 accG[4][4];
#pragma unroll
        for (int a = 0; a < 4; ++a)
#pragma unroll
          for (int b = 0; b < 4; ++b) accG[a][b] = f32x4{0.f, 0.f, 0.f, 0.f};
        gemm_mainloop_sb<128, 128>(pp, opg, opb, accG, smem);
#pragma unroll
        for (int a = 0; a < 4; ++a) {
          const float* bp = bg + n * 1024 + tn * 128 + wf * 64 + a * 16 + fq * 4;
          const float b0 = bp[0], b1 = bp[1], b2 = bp[2], b3 = bp[3];
#pragma unroll
          for (int b = 0; b < 4; ++b) {
            gp[a][b][0] = pack2(sigmoidf_(accG[a][b][0] + b0), sigmoidf_(accG[a][b][1] + b1));
            gp[a][b][1] = pack2(sigmoidf_(accG[a][b][2] + b2), sigmoidf_(accG[a][b][3] + b3));
          }
        }
      }
      f32x4 accP[4][4];
#pragma unroll
      for (int a = 0; a < 4; ++a)
#pragma unroll
        for (int b = 0; b < 4; ++b) accP[a][b] = f32x4{0.f, 0.f, 0.f, 0.f};
      gemm_mainloop_sb<128, 128>(pp, opb, opn, accP, smem);
#pragma unroll
      for (int a = 0; a < 4; ++a)
#pragma unroll
        for (int b = 0; b < 4; ++b) {
          pm[a][b][0] = pack2(bflo(pm[a][b][0]) + bflo(gp[a][b][0]) * accP[a][b][0],
                              bfhi(pm[a][b][0]) + bfhi(gp[a][b][0]) * accP[a][b][1]);
          pm[a][b][1] = pack2(bflo(pm[a][b][1]) + bflo(gp[a][b][1]) * accP[a][b][2],
                              bfhi(pm[a][b][1]) + bfhi(gp[a][b][1]) * accP[a][b][3]);
        }
    }
#pragma unroll
    for (int a = 0; a < 4; ++a) {
      const int feat = tn * 128 + wf * 64 + a * 16 + fq * 4;
#pragma unroll
      for (int b = 0; b < 4; ++b) {
        const int tok = tm * 128 + wt * 64 + b * 16 + fr;
        *(uint2*)(merged + (size_t)tok * LDH + feat) = make_uint2(pm[a][b][0], pm[a][b][1]);
      }
    }
  }
}

template <bool MLSTM>
DEV void linattn_item(const Params& p, int layer, int b, int bl, int head, char* smem) {
  const int tid = ltid(), lane = tid & 63, wv = tid >> 6, fr_ = lane & 15, fq_ = lane >> 4;
  const u16* zb = p.zreg + (size_t)bl * 2048 * ZW;
  const int CQ = (MLSTM ? 0 : 3072) + head * 128, CK = (MLSTM ? 512 : 3584) + head * 128,
            CV = (MLSTM ? 1024 : 4096) + head * 128, CO = (MLSTM ? 1536 : 4608) + head * 128;
  char* Qs = smem;
  char* Ks = smem + 16384;
  char* KwT = smem + 32768;
  char* Vt = smem + 49152;
  char* Ps = smem + 65536;
  float* A_al = (float*)(smem + 73728);
  float* A_em = A_al + 64;
  float* A_c = A_em + 64;
  float* A_M = A_c + 64;
  float* A_ws = A_M + 64;
  float* qn = A_ws + 64;
  float* part = qn + 64;
  float* stat = part + 256;
  float* nS = stat + 512;
  float* misc = nS + 128;
  u16* Y = p.br + (size_t)(MLSTM ? 0 : 2) * 32768 * LDB;
  const float* gain = (MLSTM ? p.m_norm : p.r_norm) + layer * 512 + head * 128;
  const float lg2 = MLSTM ? 0.f : log2f(1.f - exp2f(-5.f - (float)head));
  const float KSCALE = 0.08838834764831845f;

  f32x4 accC[2][8];
#pragma unroll
  for (int a = 0; a < 2; ++a)
#pragma unroll
    for (int d = 0; d < 8; ++d) accC[a][d] = f32x4{0.f, 0.f, 0.f, 0.f};
  float nreg = 0.f, mrun = 0.f;
  if (MLSTM && tid < 128) nS[tid] = 0.f;

  const int lrow_ = tid >> 2, cq_ = tid & 3;
  float4 gnv[2];
#pragma unroll
  for (int a = 0; a < 2; ++a) gnv[a] = *(const float4*)(gain + (2 * wv + a) * 16 + fq_ * 4);
  float g_li = 0.f, g_f = 0.f;
  if (MLSTM && wv == 0) {
    const float* sp = p.small + (size_t)(b * 2048 + lane) * 16;
    g_li = sp[head]; g_f = sp[4 + head];
  }
  u32x4 rq[4], rk[4], rv[4];
  {
    const u16* rowp = zb + (size_t)lrow_ * ZW;
#pragma unroll
    for (int i = 0; i < 4; ++i) {
      const int chn = cq_ + (i & 1) * 4 + (i >> 1) * 8;
      rq[i] = *(const u32x4*)(rowp + CQ + chn * 8);
      rk[i] = *(const u32x4*)(rowp + CK + chn * 8);
      rv[i] = *(const u32x4*)(rowp + CV + chn * 8);
    }
  }
  for (int ch = 0; ch < 32; ++ch) {
    const int t0 = ch * 64;
    int fr = fr_, fq = fq_, lrow = lrow_, cq = cq_;
    asm volatile("" : "+v"(fr), "+v"(fq), "+v"(lrow), "+v"(cq));
    if (ch == 0 && wv < 2) {
      const float* qk = p.qk0 + (size_t)b * 2048 + (MLSTM ? 0 : 1024) + head * 128;
      const float pr = qk[tid] * qk[512 + tid];
      const float ws_ = wave_sum(pr);
      if (lane == 0) misc[2 + wv] = ws_;
    }
    if (MLSTM && wv == 0) {
      const float li = g_li, lf = fminf(g_f, 0.f) - __builtin_amdgcn_logf(1.f + fexp(-fabsf(g_f))) * 0.6931471805599453f;
      float bcs = lf;
#pragma unroll
      for (int o = 1; o < 64; o <<= 1) { const float t = __shfl_up(bcs, o); if (lane >= o) bcs += t; }
      const float cc = li - bcs;
      float cm = cc;
#pragma unroll
      for (int o = 1; o < 64; o <<= 1) { const float t = __shfl_up(cm, o); if (lane >= o) cm = fmaxf(cm, t); }
      const float Mt = fmaxf(mrun, cm);
      A_c[lane] = cc; A_M[lane] = Mt; A_al[lane] = fexp(mrun - Mt); A_em[lane] = fexp(-(bcs + Mt));
      const float M63 = __shfl(Mt, 63), g = __shfl(bcs, 63);
      A_ws[lane] = fexp(cc - M63);
      if (lane == 0) misc[0] = fexp(mrun - M63);
      mrun = g + M63;
    }
    {
      const float beta = MLSTM ? 1.f : fexp2((float)(63 - lrow) * lg2);
      if (!MLSTM) {
        const float posf = (float)p.pos[b * 2048 + t0 + lrow];
#pragma unroll
        for (int pr = 0; pr < 2; ++pr) {
          const int chn = cq + pr * 4;
          u32 q1[4], q2[4], k1[4], k2[4];
#pragma unroll
          for (int w = 0; w < 4; ++w) {
            const u32 q1w = wsel(rq[pr], w), q2w = wsel(rq[pr + 2], w), k1w = wsel(rk[pr], w), k2w = wsel(rk[pr + 2], w);
            const int fi = chn * 8 + w * 2;
            const float rev0 = posf * (exp2f(-(float)fi * (13.287712379549449f / 64.f)) * 0.15915494309189535f);
            const float rev1 = posf * (exp2f(-(float)(fi + 1) * (13.287712379549449f / 64.f)) * 0.15915494309189535f);
            const float f0 = __builtin_amdgcn_fractf(rev0), f1 = __builtin_amdgcn_fractf(rev1);
            const float sn0 = __builtin_amdgcn_sinf(f0), cs0 = __builtin_amdgcn_cosf(f0);
            const float sn1 = __builtin_amdgcn_sinf(f1), cs1 = __builtin_amdgcn_cosf(f1);
            const float qa0 = bflo(q1w), qa1 = bfhi(q1w), qb0 = bflo(q2w), qb1 = bfhi(q2w);
            const float ka0 = bflo(k1w), ka1 = bfhi(k1w), kb0 = bflo(k2w), kb1 = bfhi(k2w);
            q1[w] = pack2(qa0 * cs0 - qb0 * sn0, qa1 * cs1 - qb1 * sn1);
            q2[w] = pack2(qa0 * sn0 + qb0 * cs0, qa1 * sn1 + qb1 * cs1);
            k1[w] = pack2(ka0 * cs0 - kb0 * sn0, ka1 * cs1 - kb1 * sn1);
            k2[w] = pack2(ka0 * sn0 + kb0 * cs0, ka1 * sn1 + kb1 * cs1);
          }
          rq[pr] = u32x4{q1[0], q1[1], q1[2], q1[3]}; rq[pr + 2] = u32x4{q2[0], q2[1], q2[2], q2[3]};
          rk[pr] = u32x4{k1[0], k1[1], k1[2], k1[3]}; rk[pr + 2] = u32x4{k2[0], k2[1], k2[2], k2[3]};
        }
      }
#pragma unroll
      for (int i = 0; i < 4; ++i) {
        const int chn = cq + (i & 1) * 4 + (i >> 1) * 8;
        *(u32x4*)(Qs + sw16(lrow, chn)) = rq[i];
        float kv[8];
#pragma unroll
        for (int w = 0; w < 4; ++w) { kv[2 * w] = bflo(wsel(rk[i], w)) * KSCALE; kv[2 * w + 1] = bfhi(wsel(rk[i], w)) * KSCALE; }
        *(uint4*)(Ks + sw16(lrow, chn)) =
            make_uint4(pack2(kv[0], kv[1]), pack2(kv[2], kv[3]), pack2(kv[4], kv[5]), pack2(kv[6], kv[7]));
#pragma unroll
        for (int e = 0; e < 8; ++e) {
          const int d = chn * 8 + e;
          if (!MLSTM) *(u16*)(KwT + sw8(d, lrow >> 3) + (lrow & 7) * 2) = f2bf(kv[e] * beta);
          const u16 ve = (u16)((wsel(rv[i], e >> 1) >> ((e & 1) * 16)) & 0xffffu);
          *(u16*)(Vt + sw8(d, lrow >> 3) + (lrow & 7) * 2) = ve;
        }
      }
    }
    __syncthreads();
    if (MLSTM) {
      const float beta = A_ws[lrow];
#pragma unroll
      for (int i = 0; i < 4; ++i) {
        const int chn = cq + (i & 1) * 4 + (i >> 1) * 8;
#pragma unroll
        for (int e = 0; e < 8; ++e) {
          const u32 w = wsel(rk[i], e >> 1);
          const float kf = ((e & 1) ? bfhi(w) : bflo(w)) * KSCALE * beta;
          *(u16*)(KwT + sw8(chn * 8 + e, lrow >> 3) + (lrow & 7) * 2) = f2bf(kf);
        }
      }
    }
    uint2 og[4][2];
#pragma unroll
    for (int t = 0; t < 4; ++t)
#pragma unroll
      for (int a = 0; a < 2; ++a)
        og[t][a] = *(const uint2*)(zb + (size_t)(t0 + t * 16 + fr) * ZW + CO + (2 * wv + a) * 16 + fq * 4);
    f32x4 num[2][4];
#pragma unroll
    for (int a = 0; a < 2; ++a)
#pragma unroll
      for (int t = 0; t < 4; ++t) num[a][t] = f32x4{0.f, 0.f, 0.f, 0.f};
#pragma unroll
    for (int pp = 0; pp < 4; ++pp) {
      bf16x8 ca[2];
#pragma unroll
      for (int a = 0; a < 2; ++a)
        ca[a] = mk8(pack2(accC[a][2 * pp][0], accC[a][2 * pp][1]), pack2(accC[a][2 * pp][2], accC[a][2 * pp][3]),
                    pack2(accC[a][2 * pp + 1][0], accC[a][2 * pp + 1][1]), pack2(accC[a][2 * pp + 1][2], accC[a][2 * pp + 1][3]));
#pragma unroll
      for (int t = 0; t < 4; ++t) {
        const int row = t * 16 + fr;
        const uint2 h0 = *(const uint2*)(Qs + sw16(row, 4 * pp + (fq >> 1)) + (fq & 1) * 8);
        const uint2 h1 = *(const uint2*)(Qs + sw16(row, 4 * pp + 2 + (fq >> 1)) + (fq & 1) * 8);
        const bf16x8 qb = mk8(h0.x, h0.y, h1.x, h1.y);
#pragma unroll
        for (int a = 0; a < 2; ++a) num[a][t] = mfma16(ca[a], qb, num[a][t]);
      }
    }
#pragma unroll
    for (int t = 0; t < 4; ++t) {
      const int tt = t * 16 + fr;
      const float al = MLSTM ? A_al[tt] : fexp2((float)(tt + 1) * lg2);
#pragma unroll
      for (int a = 0; a < 2; ++a) { num[a][t][0] *= al; num[a][t][1] *= al; num[a][t][2] *= al; num[a][t][3] *= al; }
    }
    {
      f32x4 sacc[4];
#pragma unroll
      for (int t = 0; t < 4; ++t) sacc[t] = f32x4{0.f, 0.f, 0.f, 0.f};
#pragma unroll
      for (int ks = 0; ks < 4; ++ks) {
        const bf16x8 kf = lds128(Ks + sw16(wv * 16 + fr, ks * 4 + fq));
#pragma unroll
        for (int t = 0; t < 4; ++t) sacc[t] = mfma16(kf, lds128(Qs + sw16(t * 16 + fr, ks * 4 + fq)), sacc[t]);
      }
      if (ch == 0 && wv == 0 && lane == 0) sacc[0][0] = (misc[2] + misc[3]) * KSCALE;
      const int s0 = wv * 16 + fq * 4;
      float cs4[4];
      if (MLSTM) {
#pragma unroll
        for (int j = 0; j < 4; ++j) cs4[j] = A_c[s0 + j];
      }
#pragma unroll
      for (int t = 0; t < 4; ++t) {
        const int tt = t * 16 + fr;
        const float Mt = MLSTM ? A_M[tt] : 0.f;
        float pv[4];
#pragma unroll
        for (int j = 0; j < 4; ++j) {
          const int s = s0 + j;
          float dm;
          if (MLSTM) dm = fexp(cs4[j] - Mt); else dm = fexp2((float)(tt - s) * lg2);
          pv[j] = (s <= tt) ? sacc[t][j] * dm : 0.f;
        }
        if (MLSTM) {
          float ps = pv[0] + pv[1] + pv[2] + pv[3];
          ps += __shfl_xor(ps, 16);
          ps += __shfl_xor(ps, 32);
          if (fq == 0) part[wv * 64 + tt] = ps;
        }
        *(uint2*)(Ps + sw8(tt, wv * 2 + (fq >> 1)) + (fq & 1) * 8) = make_uint2(pack2(pv[0], pv[1]), pack2(pv[2], pv[3]));
      }
    }
    if (MLSTM) {
      const int tt = tid >> 2, qt = tid & 3;
      float s = 0.f;
#pragma unroll
      for (int i = 0; i < 4; ++i) {
        const u32x4 qf = *(const u32x4*)(Qs + sw16(tt, qt * 4 + i));
        const float* np = nS + (qt * 4 + i) * 8;
#pragma unroll
        for (int w = 0; w < 4; ++w) s += bflo(wsel(qf, w)) * np[2 * w] + bfhi(wsel(qf, w)) * np[2 * w + 1];
      }
      s += __shfl_xor(s, 1);
      s += __shfl_xor(s, 2);
      if (qt == 0) qn[tt] = s;
    }
    __syncthreads();
    {
      bf16x8 vf[2][2];
#pragma unroll
      for (int a = 0; a < 2; ++a)
#pragma unroll
        for (int ks = 0; ks < 2; ++ks) vf[a][ks] = lds128(Vt + sw8((2 * wv + a) * 16 + fr, ks * 4 + fq));
#pragma unroll
      for (int t = 0; t < 4; ++t)
#pragma unroll
        for (int ks = 0; ks < 2; ++ks) {
          const bf16x8 pf = lds128(Ps + sw8(t * 16 + fr, ks * 4 + fq));
#pragma unroll
          for (int a = 0; a < 2; ++a) num[a][t] = mfma16(vf[a][ks], pf, num[a][t]);
        }
      const float delta = MLSTM ? misc[0] : fexp2(64.f * lg2);
#pragma unroll
      for (int d = 0; d < 8; ++d) {
#pragma unroll
        for (int a = 0; a < 2; ++a) { accC[a][d][0] *= delta; accC[a][d][1] *= delta; accC[a][d][2] *= delta; accC[a][d][3] *= delta; }
#pragma unroll
        for (int ks = 0; ks < 2; ++ks) {
          const bf16x8 kwf = lds128(KwT + sw8(d * 16 + fr, ks * 4 + fq));
#pragma unroll
          for (int a = 0; a < 2; ++a) accC[a][d] = mfma16(kwf, vf[a][ks], accC[a][d]);
        }
      }
      if (MLSTM && tid < 128) {
        float s = 0.f;
#pragma unroll
        for (int i = 0; i < 8; ++i) {
          const u32x4 kf = *(const u32x4*)(KwT + tid * 128 + i * 16);
#pragma unroll
          for (int w = 0; w < 4; ++w) s += bflo(wsel(kf, w)) + bfhi(wsel(kf, w));
        }
        nreg = delta * nreg + s;
        nS[tid] = nreg;
      }
    }
#pragma unroll
    for (int t = 0; t < 4; ++t) {
      const int tt = t * 16 + fr;
      float s1 = 0.f, s2 = 0.f;
      float rden = 1.f;
      if (MLSTM) {
        const float den = A_al[tt] * qn[tt] + part[tt] + part[64 + tt] + part[128 + tt] + part[192 + tt];
        rden = frcp(fmaxf(fabsf(den), A_em[tt]));
      }
#pragma unroll
      for (int a = 0; a < 2; ++a) {
        if (MLSTM) {
          const uint2 ov = og[t][a];
          num[a][t][0] *= rden * sigmoidf_(bflo(ov.x));
          num[a][t][1] *= rden * sigmoidf_(bfhi(ov.x));
          num[a][t][2] *= rden * sigmoidf_(bflo(ov.y));
          num[a][t][3] *= rden * sigmoidf_(bfhi(ov.y));
        }
#pragma unroll
        for (int j = 0; j < 4; ++j) { s1 += num[a][t][j]; s2 += num[a][t][j] * num[a][t][j]; }
      }
      s1 += __shfl_xor(s1, 16); s1 += __shfl_xor(s1, 32);
      s2 += __shfl_xor(s2, 16); s2 += __shfl_xor(s2, 32);
      if (fq == 0) { stat[(wv * 64 + tt) * 2] = s1; stat[(wv * 64 + tt) * 2 + 1] = s2; }
    }
    __syncthreads();
    {
      const int tn_ = (ch + 1 < 32) ? t0 + 64 : t0;
      if (MLSTM && wv == 0) {
        const float* sp = p.small + (size_t)(b * 2048 + tn_ + lane) * 16;
        g_li = sp[head]; g_f = sp[4 + head];
      }
      const u16* rowp = zb + (size_t)(tn_ + lrow) * ZW;
#pragma unroll
      for (int i = 0; i < 4; ++i) {
        const int chn = cq + (i & 1) * 4 + (i >> 1) * 8;
        rq[i] = *(const u32x4*)(rowp + CQ + chn * 8);
        rk[i] = *(const u32x4*)(rowp + CK + chn * 8);
        rv[i] = *(const u32x4*)(rowp + CV + chn * 8);
      }
    }
#pragma unroll
    for (int t = 0; t < 4; ++t) {
      const int tt = t * 16 + fr;
      float s1 = 0.f, s2 = 0.f;
#pragma unroll
      for (int w = 0; w < 4; ++w) { s1 += stat[(w * 64 + tt) * 2]; s2 += stat[(w * 64 + tt) * 2 + 1]; }
      const float mean = s1 * (1.f / 128.f);
      const float var = fmaxf(s2 * (1.f / 128.f) - mean * mean, 0.f);
      const float rstd = rsqrtf(var + 1e-5f);
#pragma unroll
      for (int a = 0; a < 2; ++a) {
        const int e0 = (2 * wv + a) * 16 + fq * 4;
        const float4 gn = gnv[a];
        float o0 = (num[a][t][0] - mean) * rstd * gn.x, o1 = (num[a][t][1] - mean) * rstd * gn.y;
        float o2 = (num[a][t][2] - mean) * rstd * gn.z, o3 = (num[a][t][3] - mean) * rstd * gn.w;
        if (!MLSTM) {
          const uint2 gv = og[t][a];
          const float g0 = bflo(gv.x), g1 = bfhi(gv.x), g2 = bflo(gv.y), g3 = bfhi(gv.y);
          o0 *= g0 * sigmoidf_(g0); o1 *= g1 * sigmoidf_(g1); o2 *= g2 * sigmoidf_(g2); o3 *= g3 * sigmoidf_(g3);
        }
        *(uint2*)(Y + (size_t)(b * 2048 + t0 + tt) * LDB + head * 128 + e0) = make_uint2(pack2(o0, o1), pack2(o2, o3));
      }
    }
  }
  __syncthreads();
}

DEV void attn_item(const Params& p, int b, int bl, int head, int qb, char* smem) {
  const int tid = ltid(), lane = tid & 63, wv = tid >> 6, fr = lane & 15, fq = lane >> 4;
  const u16* zb = p.zreg + (size_t)bl * 2048 * ZW;
  const int CQ = 5120 + head * 128, CK = 5632 + head * 128, CV = 6144 + head * 128;
  char* Ks = smem;
  char* Vt = smem + 16384;
  float* F = (float*)(smem + 32768);
  float* wtot = (float*)(smem + 40960);
  const int lo = qb * 128, hi = lo + 128;
  {
    const int s0 = tid * 8;
    float v[8];
    float run = 0.f;
#pragma unroll
    for (int i = 0; i < 8; ++i) {
      float lf = 0.f;
      if (s0 < hi) lf = logsigf_(p.small[(size_t)(b * 2048 + s0 + i) * 16 + 8 + head]);
      run += lf; v[i] = run;
    }
    float incl = run;
#pragma unroll
    for (int o = 1; o < 64; o <<= 1) { const float t = __shfl_up(incl, o); if (lane >= o) incl += t; }
    if (lane == 63) wtot[wv] = incl;
    __syncthreads();
    float off = incl - run;
    for (int w = 0; w < wv; ++w) off += wtot[w];
#pragma unroll
    for (int i = 0; i < 8; ++i) F[s0 + i] = (off + v[i]) * LOG2E;
  }
  bf16x8 qf[2][4];
  const int qrow0 = lo + wv * 32;
#pragma unroll
  for (int qi = 0; qi < 2; ++qi)
#pragma unroll
    for (int ks = 0; ks < 4; ++ks)
      qf[qi][ks] = *(const bf16x8*)(zb + (size_t)(qrow0 + qi * 16 + fr) * ZW + CQ + ks * 32 + fq * 8);
  __syncthreads();
  float Fq[2], mrow[2], lrow[2];
#pragma unroll
  for (int qi = 0; qi < 2; ++qi) { Fq[qi] = F[qrow0 + qi * 16 + fr]; mrow[qi] = -INFINITY; lrow[qi] = 0.f; }
  f32x4 o[8][2];
#pragma unroll
  for (int e = 0; e < 8; ++e)
#pragma unroll
    for (int qi = 0; qi < 2; ++qi) o[e][qi] = f32x4{0.f, 0.f, 0.f, 0.f};
  const float SC = 0.08838834764831845f * LOG2E;
  const int nkt = (qb + 1) * 2;
  const int krow = tid >> 2, kc = tid & 3;
  u32x4 rk[4], rv[4];
  {
    const u16* rp = zb + (size_t)krow * ZW;
#pragma unroll
    for (int i = 0; i < 4; ++i) { rk[i] = *(const u32x4*)(rp + CK + (kc * 4 + i) * 8); rv[i] = *(const u32x4*)(rp + CV + (kc * 4 + i) * 8); }
  }
  for (int kt = 0; kt < nkt; ++kt) {
    __syncthreads();
#pragma unroll
    for (int i = 0; i < 4; ++i) {
      const int chn = kc * 4 + i;
      *(u32x4*)(Ks + sw16(krow, chn)) = rk[i];
#pragma unroll
      for (int e = 0; e < 8; ++e) {
        const u16 ve = (u16)((wsel(rv[i], e >> 1) >> ((e & 1) * 16)) & 0xffffu);
        *(u16*)(Vt + sw8(chn * 8 + e, krow >> 3) + (krow & 7) * 2) = ve;
      }
    }
    __syncthreads();
    const int key0 = kt * 64;
    const bool active = (key0 <= qrow0 + 31);
    bf16x8 pb[2][2];
    if (active) {
      f32x4 s[4][2];
#pragma unroll
      for (int a = 0; a < 4; ++a)
#pragma unroll
        for (int qi = 0; qi < 2; ++qi) s[a][qi] = f32x4{0.f, 0.f, 0.f, 0.f};
#pragma unroll
      for (int ks = 0; ks < 4; ++ks)
#pragma unroll
        for (int a = 0; a < 4; ++a) {
          const bf16x8 kf = lds128(Ks + sw16(a * 16 + fr, ks * 4 + fq));
#pragma unroll
          for (int qi = 0; qi < 2; ++qi) s[a][qi] = mfma16(kf, qf[qi][ks], s[a][qi]);
        }
      const bool need_mask = (key0 + 63 > qrow0);
      float mx[2] = {-INFINITY, -INFINITY};
#pragma unroll
      for (int a = 0; a < 4; ++a) {
        const float4 fk = *(const float4*)(F + key0 + a * 16 + fq * 4);
#pragma unroll
        for (int qi = 0; qi < 2; ++qi) {
          const int qpos = qrow0 + qi * 16 + fr;
#pragma unroll
          for (int j = 0; j < 4; ++j) {
            float xv = s[a][qi][j] * SC + Fq[qi] - (j == 0 ? fk.x : (j == 1 ? fk.y : (j == 2 ? fk.z : fk.w)));
            if (need_mask && (key0 + a * 16 + fq * 4 + j > qpos)) xv = -INFINITY;
            s[a][qi][j] = xv;
            mx[qi] = fmaxf(mx[qi], xv);
          }
        }
      }
#pragma unroll
      for (int qi = 0; qi < 2; ++qi) {
        float m = mx[qi];
        m = fmaxf(m, __shfl_xor(m, 16));
        m = fmaxf(m, __shfl_xor(m, 32));
        const float mnew = fmaxf(mrow[qi], m);
        const float alpha = fexp2(mrow[qi] - mnew);
        mrow[qi] = mnew;
        float rs = 0.f;
#pragma unroll
        for (int a = 0; a < 4; ++a)
#pragma unroll
          for (int j = 0; j < 4; ++j) { const float pv = fexp2(s[a][qi][j] - mnew); s[a][qi][j] = pv; rs += pv; }
        rs += __shfl_xor(rs, 16);
        rs += __shfl_xor(rs, 32);
        lrow[qi] = lrow[qi] * alpha + rs;
#pragma unroll
        for (int e = 0; e < 8; ++e) { o[e][qi][0] *= alpha; o[e][qi][1] *= alpha; o[e][qi][2] *= alpha; o[e][qi][3] *= alpha; }
#pragma unroll
        for (int pp = 0; pp < 2; ++pp) {
          pb[qi][pp] = mk8(pack2(s[2 * pp][qi][0], s[2 * pp][qi][1]), pack2(s[2 * pp][qi][2], s[2 * pp][qi][3]),
                           pack2(s[2 * pp + 1][qi][0], s[2 * pp + 1][qi][1]), pack2(s[2 * pp + 1][qi][2], s[2 * pp + 1][qi][3]));
        }
      }
    }
    if (kt + 1 < nkt) {
      const u16* rp = zb + (size_t)((kt + 1) * 64 + krow) * ZW;
#pragma unroll
      for (int i = 0; i < 4; ++i) { rk[i] = *(const u32x4*)(rp + CK + (kc * 4 + i) * 8); rv[i] = *(const u32x4*)(rp + CV + (kc * 4 + i) * 8); }
    }
    if (active) {
#pragma unroll
      for (int pp = 0; pp < 2; ++pp)
#pragma unroll
        for (int e = 0; e < 8; ++e) {
          const int row = e * 16 + fr;
          const uint2 h0 = *(const uint2*)(Vt + sw8(row, 4 * pp + (fq >> 1)) + (fq & 1) * 8);
          const uint2 h1 = *(const uint2*)(Vt + sw8(row, 4 * pp + 2 + (fq >> 1)) + (fq & 1) * 8);
          const bf16x8 va = mk8(h0.x, h0.y, h1.x, h1.y);
#pragma unroll
          for (int qi = 0; qi < 2; ++qi) o[e][qi] = mfma16(va, pb[qi][pp], o[e][qi]);
        }
    }
  }
  u16* Y = p.br + (size_t)3 * 32768 * LDB;
#pragma unroll
  for (int qi = 0; qi < 2; ++qi) {
    const float rl = 1.f / lrow[qi];
    const int tok = b * 2048 + qrow0 + qi * 16 + fr;
#pragma unroll
    for (int e = 0; e < 8; ++e) {
      *(uint2*)(Y + (size_t)tok * LDB + head * 128 + e * 16 + fq * 4) =
          make_uint2(pack2(o[e][qi][0] * rl, o[e][qi][1] * rl), pack2(o[e][qi][2] * rl, o[e][qi][3] * rl));
    }
  }
  __syncthreads();
}

DEV void lru_item(const Params& p, int layer, int b, int bl, int n, int eh, char* smem) {
  const int tid = ltid(), lane = tid & 63, wv = tid >> 6, fr = lane & 15, fq = lane >> 4;
  const u16* zb = p.zreg + (size_t)bl * 2048 * ZW;
  const int CX = 2048 + n * 64, CG = 2560 + n * 64 + eh * 32;
  char* WaT = smem;
  char* WxT = smem + 4096;
  char* XcB = smem + 8192;
  float* XcF = (float*)(smem + 16384);
  float* aS = (float*)(smem + 24576);
  float* segP = (float*)(smem + 32768);
  float* segH = segP + 256;
  u16* Y = p.br + (size_t)1 * 32768 * LDB;
  {
    const float* wa = p.lru_wa + ((size_t)layer * 8 + n) * 4096;
    const float* wx = p.lru_wx + ((size_t)layer * 8 + n) * 4096;
    for (int i = tid; i < 2048; i += 256) {
      const int d = i >> 5, e = i & 31;
      *(u16*)(WaT + sw8(e, d >> 3) + (d & 7) * 2) = f2bf(wa[d * 64 + eh * 32 + e]);
      *(u16*)(WxT + sw8(e, d >> 3) + (d & 7) * 2) = f2bf(wx[d * 64 + eh * 32 + e]);
    }
  }
  const int c = tid & 63, sg = tid >> 6;
  const int chb = layer * 512 + n * 64;
  const float cw0 = p.conv_w[(layer * 4 + 0) * 512 + n * 64 + c], cw1 = p.conv_w[(layer * 4 + 1) * 512 + n * 64 + c],
              cw2 = p.conv_w[(layer * 4 + 2) * 512 + n * 64 + c], cw3 = p.conv_w[(layer * 4 + 3) * 512 + n * 64 + c];
  const float cb = p.conv_b[chb + c];
  const int esub = wv & 1, tp = wv >> 1;
  float ba[4], bx[4], spl[4];
#pragma unroll
  for (int j = 0; j < 4; ++j) {
    const int e = chb + eh * 32 + esub * 16 + fq * 4 + j;
    ba[j] = p.lru_ba[e]; bx[j] = p.lru_bx[e];
    const float lam = p.lru_lam[e];
    spl[j] = fmaxf(-lam, 0.f) + log1pf(expf(-fabsf(lam)));
  }
  const int sc = tid & 31, ss = tid >> 5;
  float carry = 0.f;
  for (int chk = 0; chk < 32; ++chk) {
    const int t0 = chk * 64;
    {
      float xm3 = 0.f, xm2 = 0.f, xm1 = 0.f;
      const int tb = t0 + sg * 16;
      if (tb >= 3) {
        xm3 = bf2f(zb[(size_t)(tb - 3) * ZW + CX + c]);
        xm2 = bf2f(zb[(size_t)(tb - 2) * ZW + CX + c]);
        xm1 = bf2f(zb[(size_t)(tb - 1) * ZW + CX + c]);
      }
      float xin[16];
#pragma unroll
      for (int i = 0; i < 16; ++i) xin[i] = bf2f(zb[(size_t)(tb + i) * ZW + CX + c]);
#pragma unroll
      for (int i = 0; i < 16; ++i) {
        const float x0 = xin[i];
        const float xc = cb + cw0 * xm3 + cw1 * xm2 + cw2 * xm1 + cw3 * x0;
        xm3 = xm2; xm2 = xm1; xm1 = x0;
        const int tok = sg * 16 + i;
        if ((c >> 5) == eh) XcF[tok * 32 + (c & 31)] = xc;
        *(u16*)(XcB + sw8(tok, c >> 3) + (c & 7) * 2) = f2bf(xc);
      }
    }
    __syncthreads();
    {
      f32x4 ga[2], gx[2];
#pragma unroll
      for (int t = 0; t < 2; ++t) { ga[t] = f32x4{0.f, 0.f, 0.f, 0.f}; gx[t] = f32x4{0.f, 0.f, 0.f, 0.f}; }
#pragma unroll
      for (int ks = 0; ks < 2; ++ks) {
        const bf16x8 af = lds128(WaT + sw8(esub * 16 + fr, ks * 4 + fq));
        const bf16x8 xf = lds128(WxT + sw8(esub * 16 + fr, ks * 4 + fq));
#pragma unroll
        for (int t = 0; t < 2; ++t) {
          const bf16x8 tf = lds128(XcB + sw8((tp * 2 + t) * 16 + fr, ks * 4 + fq));
          ga[t] = mfma16(af, tf, ga[t]);
          gx[t] = mfma16(xf, tf, gx[t]);
        }
      }
#pragma unroll
      for (int t = 0; t < 2; ++t) {
        const int tok = (tp * 2 + t) * 16 + fr;
#pragma unroll
        for (int j = 0; j < 4; ++j) {
          const int e = esub * 16 + fq * 4 + j;
          const float r = sigmoidf_(ga[t][j] + ba[j]);
          const float ig = sigmoidf_(gx[t][j] + bx[j]);
          const float la = -8.f * r * spl[j];
          const float a = fexp(la);
          const float u = sqrtf(fmaxf(-expm1f(2.f * la), 0.f)) * ig * XcF[tok * 32 + e];
          aS[tok * 32 + e] = a;
          XcF[tok * 32 + e] = u;
        }
      }
    }
    __syncthreads();
    {
      float hl[8], pc[8];
      float hh = 0.f, pp = 1.f;
#pragma unroll
      for (int i = 0; i < 8; ++i) {
        const int tok = ss * 8 + i;
        const float a = aS[tok * 32 + sc], u = XcF[tok * 32 + sc];
        hh = a * hh + u; pp *= a;
        hl[i] = hh; pc[i] = pp;
      }
      segP[ss * 32 + sc] = pp; segH[ss * 32 + sc] = hh;
      float gte[8];
#pragma unroll
      for (int i = 0; i < 8; ++i) gte[i] = bf2f(zb[(size_t)(t0 + ss * 8 + i) * ZW + CG + sc]);
      __syncthreads();
      float cin = carry, call = carry;
#pragma unroll
      for (int s = 0; s < 8; ++s) {
        call = segP[s * 32 + sc] * call + segH[s * 32 + sc];
        if (s + 1 == ss) cin = call;
      }
      carry = call;
#pragma unroll
      for (int i = 0; i < 8; ++i) {
        const int t = t0 + ss * 8 + i;
        const float hv = hl[i] + pc[i] * cin;
        const float g = gte[i];
        const float ge = g * sigmoidf_(1.5957691216057308f * (g + 0.044715f * g * g * g));
        Y[(size_t)(b * 2048 + t) * LDB + n * 64 + eh * 32 + sc] = f2bf(hv * ge);
      }
    }
    __syncthreads();
  }
}

DEV void phase_branches(const Params& p, int layer, int half, char* smem) {
  unsigned* ctr = p.bar + 4 + 64 * (layer * 2 + half);
  int* s_item = (int*)(smem + SMEM_BYTES - 16);
  const int bid = blockIdx.x;
  for (int it = bid; it < 64; it += gridDim.x) {
    const int k = it & 31, bl = k >> 2, head = k & 3;
    if (it < 32) linattn_item<true>(p, layer, half * 8 + bl, bl, head, smem);
    else linattn_item<false>(p, layer, half * 8 + bl, bl, head, smem);
  }
  for (;;) {
    if (threadIdx.x == 0) *s_item = (int)atomicAdd(ctr, 1u) + 64;
    __syncthreads();
    const int it = *s_item;
    __syncthreads();
    if (it >= 704) break;
    if (it < 192) {
      const int idx = it - 64, bl = idx >> 4, n = (idx >> 1) & 7, eh = idx & 1;
      lru_item(p, layer, half * 8 + bl, bl, n, eh, smem);
    } else {
      const int idx = it - 192;
      const int qb = 15 - (idx >> 5), bh = idx & 31, bl = bh >> 2, head = bh & 3;
      attn_item(p, half * 8 + bl, bl, head, qb, smem);
    }
  }
}

constexpr int PH_PER_LAYER = 10;
constexpr int N_PHASES = 2 + 2 * PH_PER_LAYER;

DEV void run_phase(const Params& p, int ph, char* smem) {
  if (ph == 0) { phase_prep(p, smem); return; }
  if (ph == 1) { phase_lnmod0(p); return; }
  const int layer = (ph - 2) / PH_PER_LAYER, q = (ph - 2) % PH_PER_LAYER;
  const u16* W = p.Wb + (size_t)layer * WL;
  u16* merged = p.zreg;
  u16* ybuf = p.zreg + (size_t)32768 * LDH;
  u16* ubuf = p.zreg;
  u16* y2buf = p.zreg + (size_t)32768 * LDU;
  switch (q) {
    case 0: phase_zgemm(p, layer, 0, smem); break;
    case 1: phase_branches(p, layer, 0, smem); break;
    case 2: phase_zgemm(p, layer, 1, smem); break;
    case 3: phase_branches(p, layer, 1, smem); break;
    case 4: phase_merge(p, layer, merged, smem); break;
    case 5: phase_gemm<0>(W + OFF_WOUT, LDW1, merged, LDH, p.b_out + layer * 1024, ybuf, LDH, 1024, 1024, smem); break;
    case 6: phase_lnres(p, layer == 0 ? p.x : p.out, ybuf, layer, 0); break;
    case 7: phase_gemm<1>(W + OFF_W1, LDW1, p.h, LDH, p.b_ff1 + layer * 4096, ubuf, LDU, 4096, 1024, smem); break;
    case 8: phase_gemm<0>(W + OFF_W2, LDW4, ubuf, LDU, p.b_ff2 + layer * 1024, y2buf, LDH, 1024, 4096, smem); break;
    case 9: phase_lnres(p, p.out, y2buf, layer, 1); break;
  }
}

#define XB_XCNT(j)  (256  + 64 * (j))
#define XB_XSUB(j)  (1280 + 64 * (j))
#define XB_XGEN(j)  (2304 + 64 * (j))
#define XB_TOP      3328
#define XB_TOPGEN   3392
#define XCD_BAR_WORDS 3456
#define LAS __attribute__((address_space(3)))
DEV unsigned xb_ld(unsigned* p) { return __hip_atomic_load(p, __ATOMIC_RELAXED, __HIP_MEMORY_SCOPE_AGENT); }
DEV unsigned xb_add(unsigned* p, unsigned v) { return __hip_atomic_fetch_add(p, v, __ATOMIC_RELAXED, __HIP_MEMORY_SCOPE_AGENT); }
DEV unsigned xb_xcc_id() { return (unsigned)__builtin_amdgcn_s_getreg((3 << 11) | 20) & 0xFu; }

DEV void xcd_census(unsigned* bar, unsigned x, unsigned& nloc, unsigned& nx) {
  const unsigned G = gridDim.x;
  unsigned sum, cnt, mine;
  for (;;) {
    sum = 0u; cnt = 0u; mine = 0u;
#pragma unroll
    for (unsigned j = 0; j < 16; ++j) {
      const unsigned c = xb_ld(&bar[XB_XCNT(j)]);
      sum += c; cnt += (c > 0u) ? 1u : 0u; mine = (j == x) ? c : mine;
    }
    if (sum == G) break;
    __builtin_amdgcn_s_sleep(1);
  }
  nloc = mine > 0u ? mine : 1u; nx = cnt > 0u ? cnt : 1u;
}

DEV void xcd_barrier(unsigned* bar, unsigned x, volatile unsigned* st) {
  asm volatile("s_waitcnt vmcnt(0)" ::: "memory");
  __syncthreads();
  if (threadIdx.x == 0) {
    __builtin_amdgcn_s_waitcnt(0);
    unsigned nloc = st[0], nx = st[1];
    if (nloc == 0u) { xcd_census(bar, x, nloc, nx); st[0] = nloc; st[1] = nx; }
    const unsigned old = xb_add(&bar[XB_XSUB(x)], 1u);
    const unsigned gen = old / nloc;
    if (old + 1u == (gen + 1u) * nloc) {
      __builtin_amdgcn_fence(__ATOMIC_RELEASE, "agent");
      asm volatile("s_waitcnt vmcnt(0)" ::: "memory");
      const unsigned og = xb_add(&bar[XB_TOP], 1u);
      const unsigned tg = og / nx;
      if (og + 1u == (tg + 1u) * nx) xb_add(&bar[XB_TOPGEN], 1u);
      else { while (xb_ld(&bar[XB_TOPGEN]) == tg) __builtin_amdgcn_s_sleep(1); }
      __builtin_amdgcn_fence(__ATOMIC_ACQUIRE, "agent");
      xb_add(&bar[XB_XGEN(x)], 1u);
      asm volatile("s_waitcnt vmcnt(0)" ::: "memory");
    } else {
      while (xb_ld(&bar[XB_XGEN(x)]) == gen) __builtin_amdgcn_s_sleep(1);
      __builtin_amdgcn_fence(__ATOMIC_ACQUIRE, "agent");
      asm volatile("s_waitcnt vmcnt(0)" ::: "memory");
    }
  }
  __syncthreads();
}

#if MULTI_LAUNCH
__global__ void __launch_bounds__(256, 2) phase_kernel(Params p, int ph) {
  __shared__ __attribute__((aligned(16))) char smem[SMEM_BYTES];
  run_phase(p, ph, smem);
}
#else
__global__ void __launch_bounds__(256, 2) fwd_megakernel(Params p) {
  __shared__ __attribute__((aligned(16))) char smem[SMEM_BYTES];
  volatile unsigned* st = (volatile unsigned*)(smem + SMEM_BYTES - 32);
  const unsigned xcc = xb_xcc_id();
  if (threadIdx.x == 0) { st[0] = 0u; st[1] = 0u; (void)xb_add(&p.bar[XB_XCNT(xcc)], 1u); }
  __syncthreads();
  if (p.bar == nullptr) cg::this_grid().sync();
#define PH(n) run_phase(p, n, smem); xcd_barrier(p.bar, xcc, st);
  PH(0)
  PH(1) PH(2) PH(3) PH(4) PH(5) PH(6) PH(7) PH(8) PH(9) PH(10) PH(11)
  PH(12) PH(13) PH(14) PH(15) PH(16) PH(17) PH(18) PH(19) PH(20)
  run_phase(p, 21, smem);
#undef PH
}
#endif

extern "C" void kernel_launch(void* const* d_in, const int* in_sizes, int n_in, void* d_out, int out_size, void* d_ws,
                              size_t ws_size, hipStream_t stream) {
  Params p{};
  p.x = (const float*)d_in[0]; p.c = (const float*)d_in[1]; p.pos = (const int*)d_in[2];
  p.w_ada = (const float*)d_in[3]; p.b_ada = (const float*)d_in[4]; p.w_in = (const float*)d_in[5];
  p.b_in = (const float*)d_in[6]; p.m_norm = (const float*)d_in[7]; p.conv_w = (const float*)d_in[8];
  p.conv_b = (const float*)d_in[9]; p.lru_wa = (const float*)d_in[10]; p.lru_ba = (const float*)d_in[11];
  p.lru_wx = (const float*)d_in[12]; p.lru_bx = (const float*)d_in[13]; p.lru_lam = (const float*)d_in[14];
  p.r_norm = (const float*)d_in[15]; p.w_br = (const float*)d_in[16]; p.w_out = (const float*)d_in[17];
  p.b_out = (const float*)d_in[18]; p.ln1_g = (const float*)d_in[19]; p.ln1_b = (const float*)d_in[20];
  p.w_ff1 = (const float*)d_in[21]; p.b_ff1 = (const float*)d_in[22]; p.w_ff2 = (const float*)d_in[23];
  p.b_ff2 = (const float*)d_in[24]; p.ln2_g = (const float*)d_in[25]; p.ln2_b = (const float*)d_in[26];
  p.out = (float*)d_out;
  char* ws = (char*)d_ws;
  size_t off = 0;
  p.Wb = (u16*)(ws + off); off += 2 * WL * 2;
  p.h = (u16*)(ws + off); off += (size_t)32768 * LDH * 2;
  p.zreg = (u16*)(ws + off); off += (size_t)16384 * ZW * 2;
  p.br = (u16*)(ws + off); off += (size_t)4 * 32768 * LDB * 2;
  p.small = (float*)(ws + off); off += (size_t)32768 * 16 * 4;
  p.mod = (float*)(ws + off); off += (size_t)2 * 16 * 6144 * 4;
  p.h0f = (float*)(ws + off); off += (size_t)16 * 1024 * 4;
  p.qk0 = (float*)(ws + off); off += (size_t)16 * 2048 * 4;
  p.bar = (unsigned*)(ws + off); off += XCD_BAR_WORDS * 4;
  hipMemsetAsync(p.bar, 0, XCD_BAR_WORDS * 4, stream);
  static int grid_blocks = 0;
  if (!grid_blocks) {
    int dev = 0, cus = 0, per_cu = 0;
    hipGetDevice(&dev);
    hipDeviceGetAttribute(&cus, hipDeviceAttributeMultiprocessorCount, dev);
#if MULTI_LAUNCH
    hipOccupancyMaxActiveBlocksPerMultiprocessor(&per_cu, phase_kernel, 256, 0);
#else
    hipOccupancyMaxActiveBlocksPerMultiprocessor(&per_cu, fwd_megakernel, 256, 0);
#endif
    if (per_cu < 1) per_cu = 1;
    if (per_cu > 2) per_cu = 2;
    grid_blocks = cus * per_cu;
  }
#if MULTI_LAUNCH
  for (int ph = 0; ph < N_PHASES; ++ph) hipLaunchKernelGGL(phase_kernel, dim3(grid_blocks), dim3(256), 0, stream, p, ph);
#else
  void* args[] = {&p};
  hipError_t e = hipLaunchCooperativeKernel((void*)fwd_megakernel, dim3(grid_blocks), dim3(256), args, 0, stream);
  if (e != hipSuccess) fprintf(stderr, "cooperative launch failed: %s (grid %d)\n", hipGetErrorString(e), grid_blocks);
#endif
}
```
